# Optimizing an MI355X kernel written in HIP

```python
import jax, jax.numpy as jnp
from jax import lax
import numpy as np

D_MODEL = 2048
BATCH = 32
SEQ = 256
DEPTH = 4
DEC_BATCH = 2
DEC_SEQ = 1024
PAST_LEN = 512

GRID_W = 64
CHUNK = 128
QBLOCK = 128
A_WIDTH = 1024
A_GROUPS = 8
A_GDIM = A_WIDTH // A_GROUPS
NA_HEADS = 16
NA_HEAD_DIM = 64
NA_WIDTH = NA_HEADS * NA_HEAD_DIM
NA_KH_MAX = 8
NA_KW = 16
D_FF = 4 * D_MODEL
ROPE_THETA = 10000.0
EPS = 1e-6
N_MOD = 6
IN_COLS = 2 * A_WIDTH + 3 * NA_WIDTH + 2 * D_MODEL
SPLITS = [int(s) for s in np.cumsum([A_WIDTH, A_WIDTH, NA_WIDTH, NA_WIDTH, NA_WIDTH, D_MODEL])]

kernel_name = 'hybrid_gmlp_natten_prefix_diffusion_step'


def _rmsnorm(x, g):
    xf = x.astype(jnp.float32)
    y = xf * lax.rsqrt(jnp.mean(xf * xf, axis=-1, keepdims=True) + EPS)
    return (y * g.astype(jnp.float32)).astype(x.dtype)


def _layernorm(x, g, b):
    xf = x.astype(jnp.float32)
    mu = jnp.mean(xf, axis=-1, keepdims=True)
    var = jnp.mean(jnp.square(xf - mu), axis=-1, keepdims=True)
    y = (xf - mu) * lax.rsqrt(var + EPS) * g.astype(jnp.float32) + b.astype(jnp.float32)
    return y.astype(x.dtype)


def _modulation(cvec, w_mod, b_mod):
    m = jax.nn.silu(cvec) @ w_mod + b_mod
    return jnp.split(m[:, None, :], N_MOD, axis=-1)


def _spatial_gating(au, av, ln_g, ln_b, w_s, b_s):
    bsz, seq, _ = au.shape
    u = jax.nn.gelu(au)
    v = _layernorm(jax.nn.gelu(av), ln_g, ln_b)
    v = v.reshape(bsz, seq // CHUNK, CHUNK, A_GROUPS, A_GDIM)
    s = jnp.einsum('gij,bnjgd->bnigd', w_s, v) + b_s.T[None, None, :, :, None]
    return u * s.reshape(bsz, seq, A_WIDTH)


def _heads(x):
    b, l, _ = x.shape
    return x.reshape(b, l, NA_HEADS, NA_HEAD_DIM).transpose(0, 2, 1, 3)


def _merge_heads(x):
    b, h, l, d = x.shape
    return x.transpose(0, 2, 1, 3).reshape(b, l, h * d)


def _rope_axis(x, pos):
    half = x.shape[-1] // 2
    freqs = ROPE_THETA ** (-jnp.arange(half, dtype=jnp.float32) / half)
    ang = pos.astype(jnp.float32)[:, None] * freqs[None, :]
    cos, sin = jnp.cos(ang), jnp.sin(ang)
    xf = x.astype(jnp.float32)
    x1, x2 = xf[..., :half], xf[..., half:]
    return jnp.concatenate([x1 * cos - x2 * sin, x2 * cos + x1 * sin], axis=-1).astype(x.dtype)


def _rope_2d(x):
    t = jnp.arange(x.shape[-2])
    hd = NA_HEAD_DIM // 2
    return jnp.concatenate([_rope_axis(x[..., :hd], t // GRID_W), _rope_axis(x[..., hd:], t % GRID_W)], axis=-1)


def _context_attention(q, k, v):
    b, h, l, d = q.shape
    nb = l // QBLOCK
    scale = d ** -0.5
    qb = q.reshape(b, h, nb, QBLOCK, d).transpose(2, 0, 1, 3, 4)

    def block(qi):
        s = jnp.einsum('bhqd,bhkd->bhqk', qi, k).astype(jnp.float32) * scale
        p = jax.nn.softmax(s, axis=-1).astype(v.dtype)
        return jnp.einsum('bhqk,bhkd->bhqd', p, v)

    o = lax.map(block, qb)
    return o.transpose(1, 2, 0, 3, 4).reshape(b, h, l, d)


def _neighbourhood_attention(q, k, v, k_ctx, v_ctx, rpb):
    b, h, t, d = q.shape
    rows = t // GRID_W
    kh = min(NA_KH_MAX, rows)
    scale = d ** -0.5
    qg = q.reshape(b, h, rows, GRID_W, d)
    kg = k.reshape(b, h, rows, GRID_W, d)
    vg = v.reshape(b, h, rows, GRID_W, d)
    cols = np.arange(GRID_W)
    cstart = np.clip(cols - NA_KW // 2, 0, GRID_W - NA_KW)
    col_mask = jnp.asarray((cols[None, :] >= cstart[:, None]) & (cols[None, :] < cstart[:, None] + NA_KW))
    col_idx = jnp.asarray(np.clip(cols[None, :] - cols[:, None] + NA_KW - 1, 0, 2 * NA_KW - 2))

    def row_block(r):
        rs = jnp.clip(r - kh // 2, 0, rows - kh)
        k_rows = lax.dynamic_slice_in_dim(kg, rs, kh, axis=2)
        v_rows = lax.dynamic_slice_in_dim(vg, rs, kh, axis=2)
        q_row = lax.dynamic_index_in_dim(qg, r, axis=2, keepdims=False)
        row_idx = rs + jnp.arange(kh) - r + NA_KH_MAX - 1
        bias = rpb[:, row_idx][:, :, col_idx].transpose(0, 2, 1, 3)
        s_win = jnp.einsum('bhqd,bhiwd->bhqiw', q_row, k_rows).astype(jnp.float32) * scale + bias.astype(jnp.float32)
        s_win = jnp.where(col_mask[:, None, :], s_win, -jnp.inf)
        s_ctx = jnp.einsum('bhqd,bhkd->bhqk', q_row, k_ctx).astype(jnp.float32) * scale
        s = jnp.concatenate([s_win.reshape(b, h, GRID_W, kh * GRID_W), s_ctx], axis=-1)
        p = jax.nn.softmax(s, axis=-1).astype(v.dtype)
        p_win = p[..., :kh * GRID_W].reshape(b, h, GRID_W, kh, GRID_W)
        p_ctx = p[..., kh * GRID_W:]
        return jnp.einsum('bhqiw,bhiwd->bhqd', p_win, v_rows) + jnp.einsum('bhqk,bhkd->bhqd', p_ctx, v_ctx)

    o = lax.map(row_block, jnp.arange(rows))
    return o.transpose(1, 2, 0, 3, 4).reshape(b, h, t, d)


def _layer(x, cvec, p, attend):
    shift1, scale1, gate1, shift2, scale2, gate2 = _modulation(cvec, p['w_mod'], p['b_mod'])
    h = _rmsnorm(x, p['g_pre_mix']) * (1 + scale1) + shift1
    au, av, q, k, v, ga, gb = jnp.split(h @ p['w_in'], SPLITS, axis=-1)
    ya = _spatial_gating(au, av, p['sgu_ln_g'], p['sgu_ln_b'], p['sgu_w'], p['sgu_b'])
    yb, extra = attend(_heads(q), _heads(k), _heads(v))
    merged = jax.nn.sigmoid(ga) * (ya @ p['w_pa']) + jax.nn.sigmoid(gb) * (_merge_heads(yb) @ p['w_pb'])
    x = x + gate1 * _rmsnorm(merged @ p['w_out'], p['g_post_mix'])
    h = _rmsnorm(x, p['g_pre_ffn']) * (1 + scale2) + shift2
    f = jnp.square(jax.nn.relu(h @ p['w_ff1'])) @ p['w_ff2']
    x = x + gate2 * _rmsnorm(f, p['g_post_ffn'])
    return x, extra


def setup_inputs(seed: int = 0) -> dict:
    key = jax.random.key(seed)
    ks = jax.random.split(key, 24)
    f32 = jnp.float32
    nrm = lambda k, shape, s: jax.random.normal(k, shape, f32) * s
    return {
        'x_prompt': nrm(ks[0], (BATCH, SEQ, D_MODEL), 1.0),
        'x_sample': nrm(ks[1], (DEC_BATCH, DEC_SEQ, D_MODEL), 1.0),
        'cache_ctx_k': nrm(ks[2], (DEC_BATCH, DEPTH, NA_HEADS, PAST_LEN, NA_HEAD_DIM), 1.0),
        'cache_ctx_v': nrm(ks[3], (DEC_BATCH, DEPTH, NA_HEADS, PAST_LEN, NA_HEAD_DIM), 1.0),
        'c': nrm(ks[4], (DEC_BATCH, D_MODEL), 1.0),
        'c_ctx': nrm(ks[5], (D_MODEL,), 1.0),
        'w_mod': nrm(ks[6], (DEPTH, D_MODEL, N_MOD * D_MODEL), 0.5 * D_MODEL ** -0.5),
        'b_mod': nrm(ks[7], (DEPTH, N_MOD * D_MODEL), 0.01),
        'g_pre_mix': 1.0 + nrm(ks[8], (DEPTH, D_MODEL), 0.01),
        'g_post_mix': 1.0 + nrm(ks[9], (DEPTH, D_MODEL), 0.01),
        'g_pre_ffn': 1.0 + nrm(ks[10], (DEPTH, D_MODEL), 0.01),
        'g_post_ffn': 1.0 + nrm(ks[11], (DEPTH, D_MODEL), 0.01),
        'w_in': nrm(ks[12], (DEPTH, D_MODEL, IN_COLS), D_MODEL ** -0.5),
        'sgu_ln_g': 1.0 + nrm(ks[13], (DEPTH, A_WIDTH), 0.01),
        'sgu_ln_b': nrm(ks[14], (DEPTH, A_WIDTH), 0.01),
        'sgu_w': nrm(ks[15], (DEPTH, A_GROUPS, CHUNK, CHUNK), CHUNK ** -0.5),
        'sgu_b': 1.0 + nrm(ks[16], (DEPTH, A_GROUPS, CHUNK), 0.01),
        'na_rpb': nrm(ks[17], (DEPTH, NA_HEADS, 2 * NA_KH_MAX - 1, 2 * NA_KW - 1), 0.1),
        'w_pa': nrm(ks[18], (DEPTH, A_WIDTH, D_MODEL), A_WIDTH ** -0.5),
        'w_pb': nrm(ks[19], (DEPTH, NA_WIDTH, D_MODEL), NA_WIDTH ** -0.5),
        'w_out': nrm(ks[20], (DEPTH, D_MODEL, D_MODEL), D_MODEL ** -0.5),
        'w_ff1': nrm(ks[21], (DEPTH, D_MODEL, D_FF), D_MODEL ** -0.5),
        'w_ff2': nrm(ks[22], (DEPTH, D_FF, D_MODEL), D_FF ** -0.5),
    }


def reference(x_prompt, x_sample, cache_ctx_k, cache_ctx_v, c, c_ctx, w_mod, b_mod, g_pre_mix, g_post_mix,
              g_pre_ffn, g_post_ffn, w_in, sgu_ln_g, sgu_ln_b, sgu_w, sgu_b, na_rpb, w_pa, w_pb, w_out,
              w_ff1, w_ff2):
    xc = x_prompt
    xs = x_sample
    ks_out, vs_out = [], []
    for l in range(DEPTH):
        p = {'w_mod': w_mod[l], 'b_mod': b_mod[l], 'g_pre_mix': g_pre_mix[l], 'g_post_mix': g_post_mix[l],
             'g_pre_ffn': g_pre_ffn[l], 'g_post_ffn': g_post_ffn[l], 'w_in': w_in[l], 'sgu_ln_g': sgu_ln_g[l],
             'sgu_ln_b': sgu_ln_b[l], 'sgu_w': sgu_w[l], 'sgu_b': sgu_b[l], 'w_pa': w_pa[l], 'w_pb': w_pb[l],
             'w_out': w_out[l], 'w_ff1': w_ff1[l], 'w_ff2': w_ff2[l]}
        rpb = na_rpb[l]
        xc, (k_l, v_l) = _layer(xc, c_ctx[None, :], p, lambda q, k, v: (_context_attention(q, k, v), (k, v)))
        ks_out.append(k_l)
        vs_out.append(v_l)
        ck = cache_ctx_k[:, l]
        cv = cache_ctx_v[:, l]
        xs, _ = _layer(xs, c, p, lambda q, k, v, ck=ck, cv=cv, rpb=rpb: (
            _neighbourhood_attention(_rope_2d(q), _rope_2d(k), v, ck, cv, rpb), None))
    state_ctx_k = jnp.stack(ks_out, axis=1)
    state_ctx_v = jnp.stack(vs_out, axis=1)
    return (xc, xs, state_ctx_k, state_ctx_v)
```

```cpp
#include <hip/hip_runtime.h>
#include <cstdio>
#include <cstdint>

#ifndef PH_MASK
#define PH_MASK 0x3FF
#endif
#ifndef PROBE_DUP
#define PROBE_DUP -1
#endif
#ifndef MK_PER_PHASE
#define MK_PER_PHASE 0
#endif

constexpr int D = 2048, NCTX = 8192, NSMP = 2048, M = NCTX + NSMP, NL = 4;
constexpr int NIN = 9216, AW = 1024, NAW = 1024, DFF = 8192;
constexpr int CB = 32, CS = 256, SBT = 2, SS = 1024, PAST = 512, NH = 16, HD = 64, GW = 64, GROWS = 16;
constexpr size_t OUT_X = 0, OUT_K = (size_t)M * D, OUT_V = OUT_K + (size_t)CB * NL * NH * CS * HD, OUT_END = OUT_V + (size_t)CB * NL * NH * CS * HD;
constexpr float EPS = 1e-6f;
constexpr int NWAVES = 8, NTHREADS = 512;

typedef unsigned short bf16_t;
#define LAS __attribute__((address_space(3)))
#define GAS __attribute__((address_space(1)))

__device__ __forceinline__ unsigned f2bf(float f) { unsigned u = __builtin_bit_cast(unsigned, f); return (u + 0x7fffu + ((u >> 16) & 1u)) >> 16; }
__device__ __forceinline__ float bf2f(unsigned h) { return __builtin_bit_cast(float, h << 16); }
__device__ __forceinline__ float bflo(unsigned w) { return __builtin_bit_cast(float, w << 16); }
__device__ __forceinline__ float bfhi(unsigned w) { return __builtin_bit_cast(float, w & 0xffff0000u); }
__device__ __forceinline__ unsigned pk2(float lo, float hi) { return f2bf(lo) | (f2bf(hi) << 16); }
__device__ __forceinline__ float gelu_tanh(float x) { const float x2 = x * x; const float t = x * __builtin_fmaf(x2, -0.1029432408f, -2.302208198f);
    return x * __builtin_amdgcn_rcpf(1.f + __builtin_amdgcn_exp2f(t)); }
__device__ __forceinline__ float sigmoidf(float x) { return __builtin_amdgcn_rcpf(1.f + __builtin_amdgcn_exp2f(-1.4426950408889634f * x)); }
__device__ __forceinline__ float wave_sum(float v) {
#pragma unroll
    for (int o = 1; o < 64; o <<= 1) v += __shfl_xor(v, o);
    return v;
}

constexpr size_t MiB = 1u << 20;
constexpr size_t WS_CTL = 0, CTL_ZERO_BYTES = 64 * 1024;
constexpr size_t WS_ROPE = 1 * MiB;
constexpr size_t WS_MOD = 2 * MiB;
constexpr size_t WS_WS = 3 * MiB;
constexpr size_t WS_WIN = 4 * MiB;
constexpr size_t WS_WPAB = WS_WIN + 144 * MiB;
constexpr size_t WS_WOUT = WS_WPAB + 32 * MiB;
constexpr size_t WS_WFF1 = WS_WOUT + 32 * MiB;
constexpr size_t WS_WFF2 = WS_WFF1 + 128 * MiB;
constexpr size_t WS_CK = WS_WFF2 + 128 * MiB;
constexpr size_t WS_CV = WS_CK + 8 * MiB;
constexpr size_t WS_STATS = WS_CV + 8 * MiB;
constexpr size_t WS_H = WS_STATS + 2 * MiB;
constexpr size_t WS_U = WS_H + 40 * MiB;
constexpr size_t WS_VG = WS_U + 20 * MiB;
constexpr size_t WS_Q = WS_VG + 20 * MiB;
constexpr size_t WS_K = WS_Q + 20 * MiB;
constexpr size_t WS_V = WS_K + 20 * MiB;
constexpr size_t WS_SA = WS_V + 20 * MiB;
constexpr size_t WS_SB = WS_SA + 40 * MiB;
constexpr size_t WS_YAB = WS_SB + 40 * MiB;
constexpr size_t WS_MG = WS_YAB + 40 * MiB;
constexpr size_t WS_O = WS_MG + 40 * MiB;
constexpr size_t WS_O1 = WS_O + 40 * MiB;
constexpr size_t WS_F1 = WS_O1 + 120 * MiB;
constexpr size_t WS_XB = WS_F1 + 160 * MiB;
constexpr size_t WS_END = WS_XB + 40 * MiB;
static_assert(WS_VG - WS_U == 20 * MiB && WS_K - WS_Q == 20 * MiB && WS_V - WS_K == 20 * MiB && WS_SB - WS_SA == 40 * MiB, "EpiIn picks its destination buffer by arithmetic");
constexpr int CW_BAR = 4096;

constexpr int RING_BYTES = 131072, MISC_OFF = RING_BYTES, LDS_BYTES = RING_BYTES + 1024;
constexpr int WLDS = 16384;

struct Params {
    const float *x_prompt, *x_sample, *cache_k, *cache_v, *c, *c_ctx, *w_mod, *b_mod, *g_pre_mix, *g_post_mix, *g_pre_ffn, *g_post_ffn,
                *w_in, *sgu_ln_g, *sgu_ln_b, *sgu_w, *sgu_b, *na_rpb, *w_pa, *w_pb, *w_out, *w_ff1, *w_ff2;
    float* out; unsigned char* ws; int ph_lo, ph_hi;
};

namespace pg8 {
typedef short bf16x8 __attribute__((ext_vector_type(8)));
typedef float f32x4 __attribute__((ext_vector_type(4)));
typedef float f32x2 __attribute__((ext_vector_type(2)));
typedef unsigned u32x4 __attribute__((ext_vector_type(4)));
constexpr int BM = 256, BK = 64, HALF = 128, HTB = HALF * BK * 2, STAGE_BYTES = 8 * HTB, NXCD = 8, WGM = 8;

__host__ __device__ __forceinline__ int lds_byte(int r, int c) { const int st = (r >> 4) * 2 + (c >> 5), rr = r & 15, cc = c & 31, ob = rr * 64 + cc * 2; return st * 1024 + (ob ^ (((ob >> 9) & 1) << 5)); }
__host__ __device__ __forceinline__ void stage_rc(int b, int& R, int& C) { const int st = b / 1024, sb = b % 1024, swz = sb ^ (((sb >> 9) & 1) << 5); R = (st >> 1) * 16 + swz / 64; C = (st & 1) * 32 + (swz % 64) / 2; }
__host__ __device__ __forceinline__ int perm32(int rho) { const int n = rho >> 4, i = rho & 15; return 8 * (i >> 2) + 4 * n + (i & 3); }

struct Unit { int pm, pn, k0, nk; };
struct Gemm { const bf16_t* A; const bf16_t* Bt; int lda, ldb, K, Mr, N, pad; };

struct StaticOrder {
    int nM, nN, nwg, G, c, nkt;
    __host__ __device__ void init(int Mr, int N, int K, int G_, int c_) { nM = Mr / BM; nN = N / BM; nwg = nM * nN; G = G_; c = c_; nkt = K / BK; }
    __host__ __device__ bool next(int i, Unit& u) const {
        const long Lx = (long)i * G + c; if (Lx >= nwg) return false;
        int wgid = (int)Lx; { const int q = nwg / NXCD, r = nwg % NXCD, xcd = wgid % NXCD, off = wgid / NXCD; wgid = (xcd < r ? xcd * (q + 1) : r * (q + 1) + (xcd - r) * q) + off; }
        const int nig = WGM * nN, gid = wgid / nig, fm = gid * WGM, gsz = (nM - fm) < WGM ? (nM - fm) : WGM;
        u.pm = fm + ((wgid % nig) % gsz); u.pn = (wgid % nig) / gsz; u.k0 = 0; u.nk = nkt; return true;
    }
};

struct TailSplit {
    StaticOrder S; int c; bool ok;
    __device__ void init(int K, int G, int c_, int bx) { ok = (G == 256); S.init(ok ? NCTX : M, D, K, G, bx); c = c_; }
    __device__ bool next(int i, Unit& u) const {
        Unit a; a.pm = 0; a.pn = 0; a.k0 = 0; a.nk = 2;
        const bool r0 = S.next(i, a);
        const bool tail = ok && (i == 1);
        const int T2 = c >> 2, q = c & 3, nk4 = S.nkt >> 2;
        u.pm = tail ? NCTX / BM + (T2 >> 3) : a.pm; u.pn = tail ? (T2 & 7) : a.pn; u.nk = tail ? nk4 : a.nk; u.k0 = tail ? q * nk4 : a.k0;
        return ok ? (i <= 1 ? (i == 0 ? r0 : true) : false) : r0;
    }
};

__device__ __forceinline__ unsigned cvt_pk_bf16(float lo, float hi) { unsigned r; asm volatile("v_cvt_pk_bf16_f32 %0, %1, %2" : "=v"(r) : "v"(lo), "v"(hi)); return r; }

struct EpiF32 {
    static constexpr bool PERM = false, MIDK = false;
    float* C; int ldc, pad;
    __device__ __forceinline__ void operator()(const f32x4 (&acc)[2][2][4][2], const Unit& u, int wr, int wc, int fr, int fq, int lane) const {
        const int row0 = u.pm * BM + wr * 64 + fr, col0 = u.pn * BM + wc * 32 + 4 * fq;
#pragma unroll
        for (int ai = 0; ai < 2; ++ai)
#pragma unroll
            for (int m = 0; m < 4; ++m) { float* rowp = C + (size_t)(row0 + ai * HALF + m * 16) * ldc + col0;
#pragma unroll
                for (int bj = 0; bj < 2; ++bj)
#pragma unroll
                    for (int n = 0; n < 2; ++n) *(f32x4*)(rowp + bj * HALF + n * 16) = acc[ai][bj][m][n]; }
    }
};
template <int ACT  > struct EpiBf16 {
    static constexpr bool PERM = true, MIDK = false;
    bf16_t* O; int ldc, pad;
    __device__ __forceinline__ void operator()(const f32x4 (&acc)[2][2][4][2], const Unit& u, int wr, int wc, int fr, int fq, int lane) const {
        const int row0 = u.pm * BM + wr * 64 + fr; const int col0 = u.pn * BM + wc * 32 + 8 * fq;
#pragma unroll
        for (int ai = 0; ai < 2; ++ai)
#pragma unroll
            for (int m = 0; m < 4; ++m) { bf16_t* rowp = O + (size_t)(row0 + ai * HALF + m * 16) * ldc + col0;
#pragma unroll
                for (int bj = 0; bj < 2; ++bj) { f32x4 v0 = acc[ai][bj][m][0], v1 = acc[ai][bj][m][1];
                    if (ACT == 2) {
#pragma unroll
                        for (int e = 0; e < 4; ++e) { const float a = fmaxf(v0[e], 0.f), b = fmaxf(v1[e], 0.f); v0[e] = a * a; v1[e] = b * b; } }
                    u32x4 w; w.x = cvt_pk_bf16(v0[0], v0[1]); w.y = cvt_pk_bf16(v0[2], v0[3]); w.z = cvt_pk_bf16(v1[0], v1[1]); w.w = cvt_pk_bf16(v1[2], v1[3]);
                    *(u32x4*)(rowp + bj * HALF) = w; } }
    }
};

struct ProbeOrder {
    StaticOrder S; int mask;
    __device__ bool next(int i, Unit& u) const { Unit a; a.pm = 0; a.pn = 0; a.k0 = 0; a.nk = 2; const bool r = S.next(i, a); u.pm = a.pm & mask; u.pn = a.pn & mask; u.k0 = a.k0; u.nk = a.nk; return r; }
};
struct EpiFixed {
    static constexpr bool PERM = true, MIDK = false;
    bf16_t* O; int pad0, pad1;
    __device__ __forceinline__ void operator()(const f32x4 (&acc)[2][2][4][2], const Unit& u, int wr, int wc, int fr, int fq, int lane) const {
        bf16_t* dst = O + (size_t)blockIdx.x * 65536;
        unsigned o0 = ((unsigned)(wr * 64 + fr) * 256u + (unsigned)(wc * 32 + 8 * fq)) * 2u;
        asm volatile("" : "+v"(o0));
#pragma unroll
        for (int ai = 0; ai < 2; ++ai)
#pragma unroll
            for (int m = 0; m < 4; ++m) {
#pragma unroll
                for (int bj = 0; bj < 2; ++bj) { const f32x4 v0 = acc[ai][bj][m][0], v1 = acc[ai][bj][m][1];
                    u32x4 w; w.x = cvt_pk_bf16(v0[0], v0[1]); w.y = cvt_pk_bf16(v0[2], v0[3]); w.z = cvt_pk_bf16(v1[0], v1[1]); w.w = cvt_pk_bf16(v1[2], v1[3]);
                    *(u32x4*)((char*)dst + o0 + (unsigned)((ai * HALF + m * 16) * 256 + bj * HALF) * 2u) = w; } }
    }
};
struct EpiNone {
    static constexpr bool PERM = true, MIDK = false;
    int pad0, pad1;
    __device__ __forceinline__ void operator()(const f32x4 (&acc)[2][2][4][2], const Unit& u, int wr, int wc, int fr, int fq, int lane) const {
#pragma unroll
        for (int ai = 0; ai < 2; ++ai)
#pragma unroll
            for (int m = 0; m < 4; ++m) asm volatile("" :: "v"(acc[ai][0][m][0]), "v"(acc[ai][0][m][1]), "v"(acc[ai][1][m][0]), "v"(acc[ai][1][m][1]));
    }
};
struct EpiPart {
    static constexpr bool PERM = true, MIDK = false;
    bf16_t* P; size_t delta; int ldc, pad;
    __device__ __forceinline__ void operator()(const f32x4 (&acc)[2][2][4][2], const Unit& u, int wr, int wc, int fr, int fq, int lane) const {
        bf16_t* dst = P + (size_t)(u.k0 / u.nk) * delta;
        unsigned o0 = ((unsigned)(u.pm * BM + wr * 64 + fr) * (unsigned)ldc + (unsigned)(u.pn * BM + wc * 32 + 8 * fq)) * 2u;
#pragma unroll
        for (int ai = 0; ai < 2; ++ai)
#pragma unroll
            for (int m = 0; m < 4; ++m) {
#pragma unroll
                for (int bj = 0; bj < 2; ++bj) { const f32x4 v0 = acc[ai][bj][m][0], v1 = acc[ai][bj][m][1];
                    u32x4 w; w.x = cvt_pk_bf16(v0[0], v0[1]); w.y = cvt_pk_bf16(v0[2], v0[3]); w.z = cvt_pk_bf16(v1[0], v1[1]); w.w = cvt_pk_bf16(v1[2], v1[3]);
                    *(u32x4*)((char*)dst + o0 + (unsigned)((ai * HALF + m * 16) * ldc + bj * HALF) * 2u) = w; } }
    }
};

__device__ __forceinline__ void st16(void* base, unsigned boff, u32x4 v) { *(u32x4*)((char*)base + boff) = v; }
__device__ __forceinline__ u32x4 ld16(const void* base, unsigned boff) { return *(const u32x4*)((const char*)base + boff); }
struct EpiIn {
    static constexpr bool PERM = true, MIDK = false;
    bf16_t *U, *Q, *SA; float* out; float2* stats; const float2* rope; int layer, pad;
    __device__ __forceinline__ void operator()(const f32x4 (&acc)[2][2][4][2], const Unit& u, int wr, int wc, int fr, int fq, int lane) const {
        const int pn = u.pn, pm = u.pm;
        const unsigned rbase = (unsigned)(pm * BM + wr * 64 + fr);
        const unsigned cloc = (unsigned)(wc * 32 + 8 * fq);
        if (pn < 8) {
            bf16_t* dst = U + (size_t)(pn >> 2) * (size_t)(WS_VG - WS_U) / 2 + (pn & 3) * 256;
            const unsigned o0 = (rbase * AW + cloc) * 2u;
            const unsigned so0 = (rbase * 16u + (unsigned)((pn - 4) * 4 + wc)) * 8u;
#pragma unroll
            for (int ai = 0; ai < 2; ++ai)
#pragma unroll
                for (int m = 0; m < 4; ++m) { float s1 = 0.f, s2 = 0.f;
#pragma unroll
                    for (int bj = 0; bj < 2; ++bj) { float g[8];
#pragma unroll
                        for (int e = 0; e < 4; ++e) { g[e] = gelu_tanh(acc[ai][bj][m][0][e]); g[4 + e] = gelu_tanh(acc[ai][bj][m][1][e]); }
#pragma unroll
                        for (int e = 0; e < 8; ++e) { s1 += g[e]; s2 += g[e] * g[e]; }
                        u32x4 w; w.x = cvt_pk_bf16(g[0], g[1]); w.y = cvt_pk_bf16(g[2], g[3]); w.z = cvt_pk_bf16(g[4], g[5]); w.w = cvt_pk_bf16(g[6], g[7]);
                        st16(dst, o0 + (unsigned)((ai * HALF + m * 16) * AW + bj * HALF) * 2u, w); }
                    if (pn >= 4) { s1 += __shfl_xor(s1, 16); s1 += __shfl_xor(s1, 32); s2 += __shfl_xor(s2, 16); s2 += __shfl_xor(s2, 32);
                        if (fq == 0) *(float2*)((char*)stats + so0 + (unsigned)((ai * HALF + m * 16) * 16 * 8)) = make_float2(s1, s2); }
                    asm volatile("" ::: "memory"); }
        } else if (pn < 20) {
            const int which = (pn - 8) >> 2, ct = (pn - 8) & 3;
            bf16_t* dst = Q + (size_t)which * (size_t)(WS_K - WS_Q) / 2 + ct * 256;
            const unsigned o0 = (rbase * NAW + cloc) * 2u;
            const bool smp = pm >= 32;
            if (smp && which < 2) {
                const int axis = wc & 1; const bool second = fq >= 2; const int fi = 8 * (fq & 1);
                float4 tq[2][4];
#define ROPE_LD(t, ai_, m_) do { const int pos_ = axis ? (16 * (m_) + fr) : (4 * ((pm - 32) & 3) + 2 * (ai_) + wr); \
                    const float4* rp_ = (const float4*)((const char*)rope + (unsigned)(pos_ * 16 + fi) * 8u); t[0] = rp_[0]; t[1] = rp_[1]; t[2] = rp_[2]; t[3] = rp_[3]; } while (0)
#pragma unroll
                for (int ai = 0; ai < 2; ++ai)
#pragma unroll
                    for (int m = 0; m < 4; ++m) {
                        if (ai == 0 && m == 0) ROPE_LD(tq[0], 0, 0);
                        if (ai * 4 + m < 7) ROPE_LD(tq[(ai * 4 + m + 1) & 1], (ai * 4 + m + 1) >> 2, (ai * 4 + m + 1) & 3);
                        const float4 t0 = tq[(ai * 4 + m) & 1][0], t1 = tq[(ai * 4 + m) & 1][1], t2 = tq[(ai * 4 + m) & 1][2], t3 = tq[(ai * 4 + m) & 1][3];
                        const float cs[8] = {t0.x, t0.z, t1.x, t1.z, t2.x, t2.z, t3.x, t3.z}, sn[8] = {t0.y, t0.w, t1.y, t1.w, t2.y, t2.w, t3.y, t3.w};
#pragma unroll
                        for (int bj = 0; bj < 2; ++bj) { float v[8], o[8];
#pragma unroll
                            for (int e = 0; e < 4; ++e) { v[e] = acc[ai][bj][m][0][e]; v[4 + e] = acc[ai][bj][m][1][e]; }
#pragma unroll
                            for (int e = 0; e < 8; ++e) { const float p = __shfl_xor(v[e], 32); o[e] = second ? (v[e] * cs[e] + p * sn[e]) : (v[e] * cs[e] - p * sn[e]); }
                            u32x4 w; w.x = cvt_pk_bf16(o[0], o[1]); w.y = cvt_pk_bf16(o[2], o[3]); w.z = cvt_pk_bf16(o[4], o[5]); w.w = cvt_pk_bf16(o[6], o[7]);
                            st16(dst, o0 + (unsigned)((ai * HALF + m * 16) * NAW + bj * HALF) * 2u, w); }
                        asm volatile("" ::: "memory"); }
            } else {
#pragma unroll
                for (int ai = 0; ai < 2; ++ai)
#pragma unroll
                    for (int m = 0; m < 4; ++m) {
#pragma unroll
                        for (int bj = 0; bj < 2; ++bj) { const f32x4 v0 = acc[ai][bj][m][0], v1 = acc[ai][bj][m][1];
                            u32x4 w; w.x = cvt_pk_bf16(v0[0], v0[1]); w.y = cvt_pk_bf16(v0[2], v0[3]); w.z = cvt_pk_bf16(v1[0], v1[1]); w.w = cvt_pk_bf16(v1[2], v1[3]);
                            st16(dst, o0 + (unsigned)((ai * HALF + m * 16) * NAW + bj * HALF) * 2u, w); }
                        asm volatile("" ::: "memory"); }
            }
        } else {
            const int t = pn - 20;
            const unsigned o0 = (rbase * D + (unsigned)(t * 128) + cloc) * 2u;
#pragma unroll
            for (int ai = 0; ai < 2; ++ai)
#pragma unroll
                for (int m = 0; m < 4; ++m) { float ga[8], gb[8];
#pragma unroll
                    for (int e = 0; e < 4; ++e) { ga[e] = sigmoidf(acc[ai][0][m][0][e]); ga[4 + e] = sigmoidf(acc[ai][0][m][1][e]);
                        gb[e] = fmaxf(sigmoidf(acc[ai][1][m][0][e]), 1e-13f); gb[4 + e] = fmaxf(sigmoidf(acc[ai][1][m][1][e]), 1e-13f); }
#pragma unroll
                    for (int e = 0; e < 8; ++e) ga[e] *= __builtin_amdgcn_rcpf(gb[e]);
                    u32x4 w; w.x = cvt_pk_bf16(ga[0], ga[1]); w.y = cvt_pk_bf16(ga[2], ga[3]); w.z = cvt_pk_bf16(ga[4], ga[5]); w.w = cvt_pk_bf16(ga[6], ga[7]);
                    st16(SA, o0 + (unsigned)((ai * HALF + m * 16) * D) * 2u, w);
                    u32x4 v; v.x = cvt_pk_bf16(gb[0], gb[1]); v.y = cvt_pk_bf16(gb[2], gb[3]); v.z = cvt_pk_bf16(gb[4], gb[5]); v.w = cvt_pk_bf16(gb[6], gb[7]);
                    st16(SA + (size_t)(WS_SB - WS_SA) / 2, o0 + (unsigned)((ai * HALF + m * 16) * D) * 2u, v);
                    asm volatile("" ::: "memory"); }
        }
    }
};

struct EpiMerge {
    static constexpr bool PERM = true, MIDK = true;
    const bf16_t *SA, *SB; bf16_t* MG;
    __device__ __forceinline__ void mid(f32x4 (&acc)[2][2][4][2], const Unit& u, int wr, int wc, int fr, int fq) const {
        unsigned o0 = ((unsigned)(u.pm * BM + wr * 64 + fr) * D + (unsigned)(u.pn * BM + wc * 32 + 8 * fq)) * 2u;
        asm volatile("" : "+v"(o0));
#pragma unroll
        for (int ai = 0; ai < 2; ++ai) {
            u32x4 a[4][2];
#pragma unroll
            for (int m = 0; m < 4; ++m)
#pragma unroll
                for (int bj = 0; bj < 2; ++bj) a[m][bj] = ld16(SA, o0 + (unsigned)((ai * HALF + m * 16) * D + bj * HALF) * 2u);
#pragma unroll
            for (int m = 0; m < 4; ++m) {
#pragma unroll
                for (int bj = 0; bj < 2; ++bj) { const u32x4 t = a[m][bj];
                    const f32x4 r0 = {bflo(t.x), bfhi(t.x), bflo(t.y), bfhi(t.y)}, r1 = {bflo(t.z), bfhi(t.z), bflo(t.w), bfhi(t.w)};
                    acc[ai][bj][m][0] *= r0; acc[ai][bj][m][1] *= r1; }
                asm volatile("" : "+v"(acc[ai][0][m][0]), "+v"(acc[ai][0][m][1]), "+v"(acc[ai][1][m][0]), "+v"(acc[ai][1][m][1])); }
            asm volatile("" ::: "memory"); }
    }
    __device__ __forceinline__ void operator()(const f32x4 (&acc)[2][2][4][2], const Unit& u, int wr, int wc, int fr, int fq, int lane) const {
        unsigned o0 = ((unsigned)(u.pm * BM + wr * 64 + fr) * D + (unsigned)(u.pn * BM + wc * 32 + 8 * fq)) * 2u;
        asm volatile("" : "+v"(o0));
#pragma unroll
        for (int ai = 0; ai < 2; ++ai) {
            u32x4 sb[4][2];
#pragma unroll
            for (int m = 0; m < 4; ++m)
#pragma unroll
                for (int bj = 0; bj < 2; ++bj) sb[m][bj] = ld16(SB, o0 + (unsigned)((ai * HALF + m * 16) * D + bj * HALF) * 2u);
#pragma unroll
            for (int m = 0; m < 4; ++m)
#pragma unroll
                for (int bj = 0; bj < 2; ++bj) { const unsigned o = o0 + (unsigned)((ai * HALF + m * 16) * D + bj * HALF) * 2u;
                    const u32x4 b = sb[m][bj];
                    const f32x4 v0 = acc[ai][bj][m][0], v1 = acc[ai][bj][m][1];
                    u32x4 w; w.x = cvt_pk_bf16(v0[0] * bflo(b.x), v0[1] * bfhi(b.x)); w.y = cvt_pk_bf16(v0[2] * bflo(b.y), v0[3] * bfhi(b.y));
                    w.z = cvt_pk_bf16(v1[0] * bflo(b.z), v1[1] * bfhi(b.z)); w.w = cvt_pk_bf16(v1[2] * bflo(b.w), v1[3] * bfhi(b.w));
                    st16(MG, o, w); }
            asm volatile("" ::: "memory"); }
    }
};

template <class Epi, class Sched, bool ALIGN_EPI = true>
__device__ __forceinline__ void gemm_phase(LAS unsigned char* lds, const Gemm g, const Sched& S, const Epi& E) {
    int tid = threadIdx.x; asm volatile("" : "+v"(tid));
    const int wid = __builtin_amdgcn_readfirstlane(tid >> 6), lane = tid & 63, wr = wid >> 2, wc = wid & 3, fr = lane & 15, fq = lane >> 4;
    unsigned voffA[2], voffB[2];
#pragma unroll
    for (int i = 0; i < 2; ++i) { int R, C; stage_rc(tid * 16 + i * 8192, R, C); const int Rb = Epi::PERM ? ((R & ~31) + perm32(R & 31)) : R;
        voffA[i] = (unsigned)(R * g.lda + C) * 2u; voffB[i] = (unsigned)(Rb * g.ldb + C) * 2u; }
    const size_t kstep = (size_t)(BK * 2);
    const size_t hsA = (size_t)HALF * g.lda * 2, hsB = (size_t)HALF * g.ldb * 2;
    const size_t tsA = 2 * hsA, tsB = 2 * hsB;
    const unsigned ldsw = (unsigned)wid * 1024u;
    const int aoff = lds_byte(wr * 64 + fr, fq * 8), boff = lds_byte(wc * 32 + fr, fq * 8);
#define PG8_SA(b, h) (((b) * 2 + (h)) * HTB)
#define PG8_SB(b, h) ((4 + (b) * 2 + (h)) * HTB)
#define PG8_STAGE(bufoff, gbase, voff) do { _Pragma("unroll") for (int _i = 0; _i < 2; ++_i) \
        __builtin_amdgcn_global_load_lds((const unsigned*)((const char*)(gbase) + (voff)[_i]), (LAS unsigned*)(lds + (bufoff) + ldsw + _i * 8192), 16, 0, 0); } while (0)
#define PG8_LDA(dst, b, h) do { _Pragma("unroll") for (int m = 0; m < 4; ++m) _Pragma("unroll") for (int k = 0; k < 2; ++k) dst[m][k] = *(const LAS bf16x8*)(lds + PG8_SA(b, h) + aoff + m * 2048 + k * 1024); } while (0)
#define PG8_LDB(dst, b, h) do { _Pragma("unroll") for (int n = 0; n < 2; ++n) _Pragma("unroll") for (int k = 0; k < 2; ++k) dst[n][k] = *(const LAS bf16x8*)(lds + PG8_SB(b, h) + boff + n * 2048 + k * 1024); } while (0)
#define PG8_MMA(ai, bj, At, Bt) do { __builtin_amdgcn_s_setprio(1); _Pragma("unroll") for (int m = 0; m < 4; ++m) _Pragma("unroll") for (int n = 0; n < 2; ++n) _Pragma("unroll") for (int k = 0; k < 2; ++k) \
        acc[ai][bj][m][n] = __builtin_amdgcn_mfma_f32_16x16x32_bf16(Bt[n][k], At[m][k], acc[ai][bj][m][n], 0, 0, 0); __builtin_amdgcn_s_setprio(0); } while (0)
#define PG8_WAIT_V(n) asm volatile("s_waitcnt vmcnt(" #n ")" ::: "memory")
#define PG8_WAIT_L(n) asm volatile("s_waitcnt lgkmcnt(" #n ")" ::: "memory")
#define PG8_BAR __builtin_amdgcn_s_barrier()
#define PG8_SCHED __builtin_amdgcn_sched_barrier(0)
    Unit cur, nxt; int ui = 0;
    if (!S.next(0, cur)) return;
    f32x4 acc[2][2][4][2];
#pragma unroll
    for (int a = 0; a < 2; ++a)
#pragma unroll
        for (int b = 0; b < 2; ++b)
#pragma unroll
            for (int m = 0; m < 4; ++m)
#pragma unroll
                for (int n = 0; n < 2; ++n) acc[a][b][m][n] = (f32x4){0.f, 0.f, 0.f, 0.f};
    bf16x8 At[4][2], B0[2][2], B1[2][2];
    const char* cA = (const char*)g.A + (size_t)cur.pm * tsA + (size_t)cur.k0 * kstep; const char* cB = (const char*)g.Bt + (size_t)cur.pn * tsB + (size_t)cur.k0 * kstep;
    PG8_STAGE(PG8_SB(0, 0), cB, voffB); PG8_STAGE(PG8_SB(0, 1), cB + hsB, voffB); PG8_STAGE(PG8_SA(0, 0), cA, voffA); PG8_STAGE(PG8_SA(0, 1), cA + hsA, voffA);
    if (wr == 1) PG8_BAR;
    PG8_WAIT_V(2); PG8_BAR;
    PG8_STAGE(PG8_SB(1, 0), cB + kstep, voffB); PG8_STAGE(PG8_SA(1, 0), cA + kstep, voffA); PG8_STAGE(PG8_SB(1, 1), cB + hsB + kstep, voffB);
    PG8_WAIT_V(6); PG8_BAR;
    for (;;) {
        const bool has_next = S.next(ui + 1, nxt);
        const char* nA = has_next ? (const char*)g.A + (size_t)nxt.pm * tsA + (size_t)nxt.k0 * kstep : cA; const char* nB = has_next ? (const char*)g.Bt + (size_t)nxt.pn * tsB + (size_t)nxt.k0 * kstep : cB;
        const int nt = cur.nk;
        for (int t = 0; t < nt; t += 2) {
            const bool last = (t == nt - 2);
            if constexpr (Epi::MIDK) { if (t == (nt >> 1)) E.mid(acc, cur, wr, wc, fr, fq); }
            const char* a1 = cA + (size_t)(t + 1) * kstep;
            const char* a2 = last ? nA : cA + (size_t)(t + 2) * kstep; const char* b2 = last ? nB : cB + (size_t)(t + 2) * kstep;
            const char* a3 = a2 + kstep; const char* b3 = b2 + kstep;
            PG8_LDB(B0, 0, 0); PG8_LDB(B1, 0, 1); PG8_SCHED; PG8_LDA(At, 0, 0); PG8_STAGE(PG8_SA(1, 1), a1 + hsA, voffA);
            PG8_WAIT_V(8); PG8_WAIT_L(0); PG8_BAR; PG8_MMA(0, 0, At, B0); PG8_MMA(0, 1, At, B1); PG8_BAR; PG8_SCHED;
            PG8_LDA(At, 0, 1); PG8_STAGE(PG8_SB(0, 0), b2, voffB); PG8_STAGE(PG8_SB(0, 1), b2 + hsB, voffB); PG8_STAGE(PG8_SA(0, 0), a2, voffA);
            PG8_WAIT_V(8); PG8_WAIT_L(0); PG8_BAR; PG8_MMA(1, 0, At, B0); PG8_MMA(1, 1, At, B1); PG8_BAR; PG8_SCHED;
            PG8_LDB(B0, 1, 0); PG8_LDB(B1, 1, 1); PG8_SCHED; PG8_LDA(At, 1, 0); PG8_STAGE(PG8_SA(0, 1), a2 + hsA, voffA);
            PG8_WAIT_V(8); PG8_WAIT_L(0); PG8_BAR; PG8_MMA(0, 0, At, B0); PG8_MMA(0, 1, At, B1); PG8_BAR; PG8_SCHED;
            PG8_LDA(At, 1, 1); PG8_STAGE(PG8_SB(1, 0), b3, voffB); PG8_STAGE(PG8_SB(1, 1), b3 + hsB, voffB); PG8_STAGE(PG8_SA(1, 0), a3, voffA);
            PG8_WAIT_V(8); PG8_WAIT_L(0); PG8_BAR; PG8_MMA(1, 0, At, B0); PG8_MMA(1, 1, At, B1); PG8_BAR; PG8_SCHED;
        }
        if constexpr (ALIGN_EPI) { if (wr == 0) PG8_BAR; }
        E(acc, cur, wr, wc, fr, fq, lane);
        if (!has_next) break;
#pragma unroll
        for (int a = 0; a < 2; ++a)
#pragma unroll
            for (int b = 0; b < 2; ++b)
#pragma unroll
                for (int m = 0; m < 4; ++m)
#pragma unroll
                    for (int n = 0; n < 2; ++n) acc[a][b][m][n] = (f32x4){0.f, 0.f, 0.f, 0.f};
        cur = nxt; cA = nA; cB = nB; ++ui;
        if constexpr (ALIGN_EPI) { if (wr == 1) PG8_BAR; }
    }
    PG8_WAIT_V(0);
    if constexpr (!ALIGN_EPI) { if (wr == 0) PG8_BAR; }
    PG8_BAR;
#undef PG8_SA
#undef PG8_SB
#undef PG8_STAGE
#undef PG8_LDA
#undef PG8_LDB
#undef PG8_MMA
#undef PG8_WAIT_V
#undef PG8_WAIT_L
#undef PG8_BAR
#undef PG8_SCHED
}
}

namespace mix {
typedef float f32x16 __attribute__((ext_vector_type(16)));
typedef float f32x4 __attribute__((ext_vector_type(4)));
typedef short bf16x8 __attribute__((ext_vector_type(8)));
typedef short s16x4 __attribute__((ext_vector_type(4)));
typedef unsigned u32x4 __attribute__((ext_vector_type(4)));
typedef unsigned u32x2 __attribute__((ext_vector_type(2)));
constexpr int VS = 144;
constexpr int RPB_OFF = 9216;
constexpr int SG_STRIDE = 80, SG_MU = 10240, SG_RS = 10240 + 512;
constexpr float SCL = 0.125f * 1.4426950408889634f, LOG2E = 1.4426950408889634f;

__device__ __forceinline__ s16x4 tr4(LAS unsigned char* p) { return __builtin_bit_cast(s16x4, __builtin_amdgcn_ds_read_tr16_b64_v4i16((LAS s16x4*)p)); }
__device__ __forceinline__ bf16x8 cat8(s16x4 a, s16x4 b) { return (bf16x8){a[0], a[1], a[2], a[3], b[0], b[1], b[2], b[3]}; }
__device__ __forceinline__ unsigned cvtpk(float lo, float hi) { unsigned r; asm volatile("v_cvt_pk_bf16_f32 %0, %1, %2" : "=v"(r) : "v"(lo), "v"(hi)); return r; }

struct FState { f32x16 o0, o1; float m, l; };

template <bool PLAIN, class Fn>
__device__ __forceinline__ void fa_block(FState& st, const bf16x8 (&qf)[4], const bf16x8 (&kf)[4], LAS unsigned char* vt, int lane, Fn&& fn) {
    f32x16 s;
#pragma unroll
    for (int r = 0; r < 16; ++r) s[r] = 0.f;
#pragma unroll
    for (int d0 = 0; d0 < 4; ++d0) s = __builtin_amdgcn_mfma_f32_32x32x16_bf16(kf[d0], qf[d0], s, 0, 0, 0);
    if (!PLAIN) fn(s);
    float mx = fmaxf(fmaxf(s[0], s[1]), s[2]);
#pragma unroll
    for (int r = 3; r < 15; r += 2) mx = fmaxf(fmaxf(mx, s[r]), s[r + 1]);
    mx = fmaxf(mx, s[15]);
    mx = fmaxf(mx, __shfl_xor(mx, 32));
    if (PLAIN) mx *= SCL;
    if (__builtin_amdgcn_ballot_w64(mx - st.m > 8.f) != 0ull) {
        const float mn = fmaxf(st.m, mx), alpha = __builtin_amdgcn_exp2f(st.m - mn);
        st.l *= alpha; st.m = mn;
#pragma unroll
        for (int r = 0; r < 16; ++r) { st.o0[r] *= alpha; st.o1[r] *= alpha; }
    }
    const float nm = -st.m; float ps = 0.f;
#pragma unroll
    for (int r = 0; r < 16; ++r) { s[r] = __builtin_amdgcn_exp2f(PLAIN ? __builtin_fmaf(s[r], SCL, nm) : (s[r] + nm)); ps += s[r]; }
    st.l += ps;
    u32x4 p0, p1;
    p0.x = cvtpk(s[0], s[1]); p0.y = cvtpk(s[2], s[3]); p0.z = cvtpk(s[4], s[5]); p0.w = cvtpk(s[6], s[7]);
    p1.x = cvtpk(s[8], s[9]); p1.y = cvtpk(s[10], s[11]); p1.z = cvtpk(s[12], s[13]); p1.w = cvtpk(s[14], s[15]);
    const bf16x8 pb0 = __builtin_bit_cast(bf16x8, p0), pb1 = __builtin_bit_cast(bf16x8, p1);
    const int h = lane >> 5, blk = (lane >> 4) & 1, qq = (lane & 15) >> 2, p = lane & 3;
    LAS unsigned char* vb = vt + (4 * h + qq) * VS + (16 * blk + 4 * p) * 2;
    const bf16x8 a00 = cat8(tr4(vb), tr4(vb + 8 * VS)), a01 = cat8(tr4(vb + 64), tr4(vb + 8 * VS + 64));
    const bf16x8 a10 = cat8(tr4(vb + 16 * VS), tr4(vb + 24 * VS)), a11 = cat8(tr4(vb + 16 * VS + 64), tr4(vb + 24 * VS + 64));
    st.o0 = __builtin_amdgcn_mfma_f32_32x32x16_bf16(a00, pb0, st.o0, 0, 0, 0);
    st.o1 = __builtin_amdgcn_mfma_f32_32x32x16_bf16(a01, pb0, st.o1, 0, 0, 0);
    st.o0 = __builtin_amdgcn_mfma_f32_32x32x16_bf16(a10, pb1, st.o0, 0, 0, 0);
    st.o1 = __builtin_amdgcn_mfma_f32_32x32x16_bf16(a11, pb1, st.o1, 0, 0, 0);
}

template <bool PLAIN, class FnA, class FnB>
__device__ __forceinline__ void fa_block2(FState& st, const bf16x8 (&qf)[4], const bf16x8 (&kfA)[4], const bf16x8 (&kfB)[4], LAS unsigned char* vtA, LAS unsigned char* vtB, int lane, FnA&& fnA, FnB&& fnB) {
    f32x16 sA, sB;
#pragma unroll
    for (int r = 0; r < 16; ++r) { sA[r] = 0.f; sB[r] = 0.f; }
#pragma unroll
    for (int d0 = 0; d0 < 4; ++d0) { sA = __builtin_amdgcn_mfma_f32_32x32x16_bf16(kfA[d0], qf[d0], sA, 0, 0, 0); sB = __builtin_amdgcn_mfma_f32_32x32x16_bf16(kfB[d0], qf[d0], sB, 0, 0, 0); }
    if (!PLAIN) { fnA(sA); fnB(sB); }
    float mxa = fmaxf(fmaxf(sA[0], sA[1]), sA[2]), mxb = fmaxf(fmaxf(sB[0], sB[1]), sB[2]);
#pragma unroll
    for (int r = 3; r < 15; r += 2) { mxa = fmaxf(fmaxf(mxa, sA[r]), sA[r + 1]); mxb = fmaxf(fmaxf(mxb, sB[r]), sB[r + 1]); }
    float mx = fmaxf(fmaxf(mxa, sA[15]), fmaxf(mxb, sB[15]));
    mx = fmaxf(mx, __shfl_xor(mx, 32));
    if (PLAIN) mx *= SCL;
    if (__builtin_amdgcn_ballot_w64(mx - st.m > 8.f) != 0ull) {
        const float mn = fmaxf(st.m, mx), alpha = __builtin_amdgcn_exp2f(st.m - mn);
        st.l *= alpha; st.m = mn;
#pragma unroll
        for (int r = 0; r < 16; ++r) { st.o0[r] *= alpha; st.o1[r] *= alpha; }
    }
    const float nm = -st.m; float psa = 0.f, psb = 0.f;
#pragma unroll
    for (int r = 0; r < 16; ++r) { sA[r] = __builtin_amdgcn_exp2f(PLAIN ? __builtin_fmaf(sA[r], SCL, nm) : (sA[r] + nm)); psa += sA[r];
                                   sB[r] = __builtin_amdgcn_exp2f(PLAIN ? __builtin_fmaf(sB[r], SCL, nm) : (sB[r] + nm)); psb += sB[r]; }
    st.l += psa + psb;
    u32x4 p0, p1, p2, p3;
    p0.x = cvtpk(sA[0], sA[1]); p0.y = cvtpk(sA[2], sA[3]); p0.z = cvtpk(sA[4], sA[5]); p0.w = cvtpk(sA[6], sA[7]);
    p1.x = cvtpk(sA[8], sA[9]); p1.y = cvtpk(sA[10], sA[11]); p1.z = cvtpk(sA[12], sA[13]); p1.w = cvtpk(sA[14], sA[15]);
    p2.x = cvtpk(sB[0], sB[1]); p2.y = cvtpk(sB[2], sB[3]); p2.z = cvtpk(sB[4], sB[5]); p2.w = cvtpk(sB[6], sB[7]);
    p3.x = cvtpk(sB[8], sB[9]); p3.y = cvtpk(sB[10], sB[11]); p3.z = cvtpk(sB[12], sB[13]); p3.w = cvtpk(sB[14], sB[15]);
    const bf16x8 pa0 = __builtin_bit_cast(bf16x8, p0), pa1 = __builtin_bit_cast(bf16x8, p1), pb0 = __builtin_bit_cast(bf16x8, p2), pb1 = __builtin_bit_cast(bf16x8, p3);
    const int h = lane >> 5, blk = (lane >> 4) & 1, qq = (lane & 15) >> 2, p = lane & 3;
    const int voff = (4 * h + qq) * VS + (16 * blk + 4 * p) * 2;
    LAS unsigned char* va = vtA + voff; LAS unsigned char* vb = vtB + voff;
    const bf16x8 a00 = cat8(tr4(va), tr4(va + 8 * VS)), a01 = cat8(tr4(va + 64), tr4(va + 8 * VS + 64));
    const bf16x8 a10 = cat8(tr4(va + 16 * VS), tr4(va + 24 * VS)), a11 = cat8(tr4(va + 16 * VS + 64), tr4(va + 24 * VS + 64));
    const bf16x8 b00 = cat8(tr4(vb), tr4(vb + 8 * VS)), b01 = cat8(tr4(vb + 64), tr4(vb + 8 * VS + 64));
    const bf16x8 b10 = cat8(tr4(vb + 16 * VS), tr4(vb + 24 * VS)), b11 = cat8(tr4(vb + 16 * VS + 64), tr4(vb + 24 * VS + 64));
    st.o0 = __builtin_amdgcn_mfma_f32_32x32x16_bf16(a00, pa0, st.o0, 0, 0, 0);
    st.o1 = __builtin_amdgcn_mfma_f32_32x32x16_bf16(a01, pa0, st.o1, 0, 0, 0);
    st.o0 = __builtin_amdgcn_mfma_f32_32x32x16_bf16(a10, pa1, st.o0, 0, 0, 0);
    st.o1 = __builtin_amdgcn_mfma_f32_32x32x16_bf16(a11, pa1, st.o1, 0, 0, 0);
    st.o0 = __builtin_amdgcn_mfma_f32_32x32x16_bf16(b00, pb0, st.o0, 0, 0, 0);
    st.o1 = __builtin_amdgcn_mfma_f32_32x32x16_bf16(b01, pb0, st.o1, 0, 0, 0);
    st.o0 = __builtin_amdgcn_mfma_f32_32x32x16_bf16(b10, pb1, st.o0, 0, 0, 0);
    st.o1 = __builtin_amdgcn_mfma_f32_32x32x16_bf16(b11, pb1, st.o1, 0, 0, 0);
}

template <bool PLAIN, class Fn>
__device__ __forceinline__ void fa_sweep(FState& st, const bf16x8 (&qf)[4], const bf16_t* kb, size_t kblk, const bf16_t* vb, size_t vpitch, size_t vblk, int nblk, LAS unsigned char* vt, int lane, Fn&& fn) {
    bf16x8 kf[4]; u32x4 vr[4];
#pragma unroll
    for (int d0 = 0; d0 < 4; ++d0) kf[d0] = *(const bf16x8*)(kb + 16 * d0);
#pragma unroll
    for (int i = 0; i < 4; ++i) vr[i] = *(const u32x4*)(vb + (size_t)(8 * i) * vpitch);
    LAS unsigned char* vw = vt + (lane >> 3) * VS + (lane & 7) * 16;
    for (int j = 0; j < nblk; ++j) {
#pragma unroll
        for (int i = 0; i < 4; ++i) *(LAS u32x4*)(vw + 8 * i * VS) = vr[i];
        bf16x8 kc[4];
#pragma unroll
        for (int d0 = 0; d0 < 4; ++d0) kc[d0] = kf[d0];
        const int jn = (j + 1 < nblk) ? j + 1 : j;
        const bf16_t* kn = kb + (size_t)jn * kblk; const bf16_t* vn = vb + (size_t)jn * vblk;
#pragma unroll
        for (int d0 = 0; d0 < 4; ++d0) kf[d0] = *(const bf16x8*)(kn + 16 * d0);
#pragma unroll
        for (int i = 0; i < 4; ++i) vr[i] = *(const u32x4*)(vn + (size_t)(8 * i) * vpitch);
        fa_block<PLAIN>(st, qf, kc, vt, lane, [&](f32x16& s) { fn(s, j); });
    }
}

template <bool PLAIN, class Fn>
__device__ __forceinline__ void fa_sweep2(FState& st, const bf16x8 (&qf)[4], const bf16_t* kb, unsigned koff, size_t kblk, const bf16_t* vb, unsigned voff, size_t vpitch, size_t vblk, int nblk, LAS unsigned char* vt, int lane, Fn&& fn) {
    bf16x8 kfa[4], kfb[4]; u32x4 vra[4], vrb[4];
    asm volatile("" : "+v"(koff), "+v"(voff));
#define FA_LDK(dst, blk) do { const char* p_ = (const char*)(kb + (size_t)(blk) * kblk); _Pragma("unroll") for (int d0 = 0; d0 < 4; ++d0) dst[d0] = *(const bf16x8*)(p_ + 32 * d0 + koff); } while (0)
#define FA_LDV(dst, blk) do { const char* p_ = (const char*)(vb + (size_t)(blk) * vblk); _Pragma("unroll") for (int i = 0; i < 4; ++i) dst[i] = *(const u32x4*)(p_ + (size_t)(8 * i) * vpitch * 2 + voff); } while (0)
    { const int j1 = nblk > 1 ? 1 : 0; FA_LDK(kfa, 0); FA_LDK(kfb, j1); FA_LDV(vra, 0); FA_LDV(vrb, j1); }
    LAS unsigned char* vw = vt + (lane >> 3) * VS + (lane & 7) * 16;
    int j = 0;
    for (; j + 1 < nblk; j += 2) {
#pragma unroll
        for (int i = 0; i < 4; ++i) { *(LAS u32x4*)(vw + 8 * i * VS) = vra[i]; *(LAS u32x4*)(vw + 32 * VS + 8 * i * VS) = vrb[i]; }
        bf16x8 kca[4], kcb[4];
#pragma unroll
        for (int d0 = 0; d0 < 4; ++d0) { kca[d0] = kfa[d0]; kcb[d0] = kfb[d0]; }
        const int ja = (j + 2 < nblk) ? j + 2 : nblk - 1, jb = (j + 3 < nblk) ? j + 3 : nblk - 1;
        FA_LDK(kfa, ja); FA_LDK(kfb, jb); FA_LDV(vra, ja); FA_LDV(vrb, jb);
        fa_block2<PLAIN>(st, qf, kca, kcb, vt, vt + 32 * VS, lane, [&](f32x16& s) { fn(s, j); }, [&](f32x16& s) { fn(s, j + 1); });
    }
    if (j < nblk) {
#pragma unroll
        for (int i = 0; i < 4; ++i) *(LAS u32x4*)(vw + 8 * i * VS) = vra[i];
        fa_block<PLAIN>(st, qf, kfa, vt, lane, [&](f32x16& s) { fn(s, j); });
    }
#undef FA_LDK
#undef FA_LDV
}

__device__ __forceinline__ void fa_init(FState& st) {
#pragma unroll
    for (int r = 0; r < 16; ++r) { st.o0[r] = 0.f; st.o1[r] = 0.f; }
    st.m = -1e30f; st.l = 0.f;
}
__device__ __forceinline__ void fa_store(const FState& st, bf16_t* dst  , int lane) {
    const int hi = lane >> 5;
    const float l = st.l + __shfl_xor(st.l, 32), inv = 1.f / l;
#pragma unroll
    for (int rg = 0; rg < 4; ++rg) {
        u32x2 w0, w1;
        w0.x = cvtpk(st.o0[4 * rg] * inv, st.o0[4 * rg + 1] * inv); w0.y = cvtpk(st.o0[4 * rg + 2] * inv, st.o0[4 * rg + 3] * inv);
        w1.x = cvtpk(st.o1[4 * rg] * inv, st.o1[4 * rg + 1] * inv); w1.y = cvtpk(st.o1[4 * rg + 2] * inv, st.o1[4 * rg + 3] * inv);
        *(u32x2*)(dst + 8 * rg + 4 * hi) = w0; *(u32x2*)(dst + 32 + 8 * rg + 4 * hi) = w1;
    }
}

template <class RowFn>
__device__ __forceinline__ void fa_store_rows(const FState& st, LAS unsigned char* tb, int lane, RowFn&& rowp) {
    const int q = lane & 31, hi = lane >> 5;
    const float l = st.l + __shfl_xor(st.l, 32), inv = 1.f / l;
    LAS unsigned char* wp = tb + q * VS + 8 * hi;
#pragma unroll
    for (int rg = 0; rg < 4; ++rg) {
        u32x2 w0, w1;
        w0.x = cvtpk(st.o0[4 * rg] * inv, st.o0[4 * rg + 1] * inv); w0.y = cvtpk(st.o0[4 * rg + 2] * inv, st.o0[4 * rg + 3] * inv);
        w1.x = cvtpk(st.o1[4 * rg] * inv, st.o1[4 * rg + 1] * inv); w1.y = cvtpk(st.o1[4 * rg + 2] * inv, st.o1[4 * rg + 3] * inv);
        *(LAS u32x2*)(wp + 16 * rg) = w0; *(LAS u32x2*)(wp + 64 + 16 * rg) = w1;
    }
#pragma unroll
    for (int i = 0; i < 4; ++i) { const int row = (lane >> 3) + 8 * i;
        const u32x4 v = *(const LAS u32x4*)(tb + row * VS + (lane & 7) * 16);
        *(u32x4*)(rowp(row) + (lane & 7) * 8) = v; }
}

struct MixArgs { const bf16_t *Q, *Kb, *Vb, *CK, *CV, *U, *VG, *Wsb; const float2* stats; const float *rpb, *lng, *lnb, *sgb; bf16_t* YAB; float* out; int layer; };

constexpr int CTX_K = 0, CTX_V = 256 * VS;
__device__ __forceinline__ void ctx_issue(const MixArgs& A, int bh, int tid, u32x4 (&kr)[4], u32x4 (&vr)[4]) {
    const int b = bh >> 4, h = bh & 15; const size_t row0 = (size_t)b * CS;
#pragma unroll
    for (int i = 0; i < 4; ++i) { const int id = tid + 512 * i, row = id >> 3, ch = id & 7;
        kr[i] = *(const u32x4*)(A.Kb + (row0 + row) * NAW + h * HD + ch * 8); vr[i] = *(const u32x4*)(A.Vb + (row0 + row) * NAW + h * HD + ch * 8); }
}
__device__ __forceinline__ void ctx_wg_phase(const MixArgs& A, LAS unsigned char* lds, int vw, int tid, int wave, int lane, bool wst) {
    asm volatile("" : "+v"(lane), "+v"(tid));
    const int r32 = lane & 31, hi = lane >> 5;
    u32x4 kr[4], vr[4];
    ctx_issue(A, 2 * vw, tid, kr, vr);
    for (int u = 0; u < 2; ++u) {
        const int bh = 2 * vw + u, b = bh >> 4, h = bh & 15; const size_t row0 = (size_t)b * CS;
        bf16x8 qf[4];
        { const bf16_t* qp = A.Q + (row0 + 32 * wave + r32) * NAW + h * HD + 8 * hi;
#pragma unroll
          for (int d0 = 0; d0 < 4; ++d0) qf[d0] = *(const bf16x8*)(qp + 16 * d0); }
#pragma unroll
        for (int i = 0; i < 4; ++i) { const int id = tid + 512 * i, row = id >> 3, ch = id & 7;
            *(LAS u32x4*)(lds + CTX_K + row * VS + ch * 16) = kr[i]; *(LAS u32x4*)(lds + CTX_V + row * VS + ch * 16) = vr[i]; }
        if (wst) {
            float* sk = A.out + OUT_K + (((size_t)b * NL + A.layer) * NH + h) * (size_t)(CS * HD);
            float* sv = sk + (OUT_V - OUT_K);
#pragma unroll
            for (int i = 0; i < 4; ++i) { const int id = tid + 512 * i; const unsigned o = (unsigned)((id >> 3) * HD + (id & 7) * 8);
                const u32x4 k4 = kr[i], v4 = vr[i];
                *(f32x4*)(sk + o) = (f32x4){bflo(k4.x), bfhi(k4.x), bflo(k4.y), bfhi(k4.y)}; *(f32x4*)(sk + o + 4) = (f32x4){bflo(k4.z), bfhi(k4.z), bflo(k4.w), bfhi(k4.w)};
                *(f32x4*)(sv + o) = (f32x4){bflo(v4.x), bfhi(v4.x), bflo(v4.y), bfhi(v4.y)}; *(f32x4*)(sv + o + 4) = (f32x4){bflo(v4.z), bfhi(v4.z), bflo(v4.w), bfhi(v4.w)}; }
        }
        if (u == 0) ctx_issue(A, bh + 1, tid, kr, vr);
        __syncthreads();
        FState st; fa_init(st);
        LAS unsigned char* kp = lds + CTX_K + r32 * VS + 16 * hi;
        for (int j = 0; j < 4; ++j) {
            bf16x8 kfa[4], kfb[4];
#pragma unroll
            for (int d0 = 0; d0 < 4; ++d0) { kfa[d0] = *(const LAS bf16x8*)(kp + (64 * j) * VS + 32 * d0); kfb[d0] = *(const LAS bf16x8*)(kp + (64 * j + 32) * VS + 32 * d0); }
            fa_block2<true>(st, qf, kfa, kfb, lds + CTX_V + (64 * j) * VS, lds + CTX_V + (64 * j + 32) * VS, lane, [&](f32x16&) {}, [&](f32x16&) {});
        }
        { bf16_t* y0 = A.YAB + (row0 + 32 * wave) * 2048 + 1024 + h * HD;
          fa_store_rows(st, lds + 2 * 256 * VS + wave * (32 * VS), lane, [&](int q) { return y0 + (size_t)q * 2048; }); }
        __syncthreads();
    }
}

__device__ __forceinline__ void smp_unit(const MixArgs& A, int su, LAS unsigned char* wl, int lane) {
    asm volatile("" : "+v"(lane));
    const int cb = su & 3, rp = (su >> 2) & 7, h = (su >> 5) & 15, b = su >> 9, r32 = lane & 31, hi = lane >> 5;
    const int qr = 2 * rp + (r32 >> 4), qc = 16 * cb + (r32 & 15);
    const size_t srow0 = (size_t)NCTX + (size_t)b * SS;
    const size_t qrow = srow0 + qr * GW + qc;
    LAS float* rl = (LAS float*)(wl + RPB_OFF);
    float tv[8];
    { const float* rp_ = A.rpb + ((size_t)A.layer * NH + h) * (15 * 31);
#pragma unroll
      for (int k = 0; k < 8; ++k) { const int i = lane + 64 * k; tv[k] = rp_[i < 15 * 31 ? i : 15 * 31 - 1]; } }
    bf16x8 qf[4];
    { const bf16_t* qp = A.Q + qrow * NAW + h * HD + 8 * hi;
#pragma unroll
      for (int d0 = 0; d0 < 4; ++d0) qf[d0] = *(const bf16x8*)(qp + 16 * d0); }
    FState st; fa_init(st);
    const size_t cbase = (((size_t)b * NL + A.layer) * NH + h) * (size_t)PAST * HD;
    fa_sweep2<true>(st, qf, A.CK + cbase, (unsigned)(r32 * HD + 8 * hi) * 2u, (size_t)32 * HD, A.CV + cbase, (unsigned)((lane >> 3) * HD + (lane & 7) * 8) * 2u, (size_t)HD, (size_t)32 * HD, PAST / 32, wl, lane,
             [&](f32x16&, int) {});
#pragma unroll
    for (int k = 0; k < 8; ++k) { const int i = lane + 64 * k; if (i < 15 * 31) rl[i] = tv[k] * LOG2E; }
    int rs0 = 2 * rp - 4; rs0 = rs0 < 0 ? 0 : (rs0 > GROWS - 8 ? GROWS - 8 : rs0);
    int rs1 = 2 * rp - 3; rs1 = rs1 < 0 ? 0 : (rs1 > GROWS - 8 ? GROWS - 8 : rs1);
    const int rsq = (r32 >> 4) ? rs1 : rs0;
    int cs0 = qc - 8; cs0 = cs0 < 0 ? 0 : (cs0 > GW - 16 ? GW - 16 : cs0);
    int c0 = 16 * cb - 8; c0 = c0 < 0 ? 0 : (c0 > 32 ? 32 : c0);
    const size_t wrow0 = srow0 + (size_t)rs0 * GW + c0;
    fa_sweep2<false>(st, qf, A.Kb + wrow0 * NAW + h * HD, (unsigned)(r32 * NAW + 8 * hi) * 2u, (size_t)GW * NAW, A.Vb + wrow0 * NAW + h * HD, (unsigned)((lane >> 3) * NAW + (lane & 7) * 8) * 2u, (size_t)NAW, (size_t)GW * NAW, rs1 + 8 - rs0, wl, lane,
             [&](f32x16& s, int j) {
                 const int kr = rs0 + j; const bool rowok = (kr >= rsq) && (kr < rsq + 8);
                 int ri = kr - qr + 7; ri = ri < 0 ? 0 : (ri > 14 ? 14 : ri);
                 const int kc0 = c0 + 4 * hi;
#pragma unroll
                 for (int rr = 0; rr < 16; ++rr) { const int kc = kc0 + (rr & 3) + 8 * (rr >> 2);
                     const bool valid = rowok && (kc >= cs0) && (kc < cs0 + 16);
                     int ci = kc - qc + 15; ci = ci < 0 ? 0 : (ci > 30 ? 30 : ci);
                     const float bias = rl[ri * 31 + ci];
                     s[rr] = valid ? __builtin_fmaf(s[rr], SCL, bias) : -INFINITY; } });
    { bf16_t* y0 = A.YAB + (srow0 + (size_t)(2 * rp) * GW + 16 * cb) * 2048 + 1024 + h * HD;
      fa_store_rows(st, wl + 11264, lane, [&](int q) { return y0 + (size_t)((q >> 4) * GW + (q & 15)) * 2048; }); }
}

__device__ __forceinline__ void sgu_unit(const MixArgs& A, int su, int db, LAS unsigned char* wl, int lane) {
    asm volatile("" : "+v"(lane));
    const int chunk = su >> 3, g = su & 7, r32 = lane & 31, hi = lane >> 5;
    const size_t row0 = (size_t)chunk * 128;
    const bf16_t* wg = A.Wsb + ((size_t)(A.layer * 8 + g) * 128 + r32) * 128 + 8 * hi;
    bf16x8 w[4][8];
#pragma unroll
    for (int ib = 0; ib < 2; ++ib)
#pragma unroll
        for (int ks = 0; ks < 8; ++ks) w[ib][ks] = *(const bf16x8*)(wg + (size_t)(32 * ib) * 128 + 16 * ks);
    LAS float* mu = (LAS float*)(wl + SG_MU); LAS float* rsd = (LAS float*)(wl + SG_RS);
#pragma unroll
    for (int k = 0; k < 2; ++k) { const int rr = lane + 64 * k; const float4* sp = (const float4*)(A.stats + (row0 + rr) * 16);
        float s1 = 0.f, s2 = 0.f;
#pragma unroll
        for (int i = 0; i < 8; ++i) { const float4 t = sp[i]; s1 += t.x + t.z; s2 += t.y + t.w; }
        const float mean = s1 * (1.f / AW), var = fmaxf(s2 * (1.f / AW) - mean * mean, 0.f);
        mu[rr] = mean; rsd[rr] = rsqrtf(var + EPS); }
    const int h = hi, blk = (lane >> 4) & 1, qq = (lane & 15) >> 2, p = lane & 3;
    LAS unsigned char* tb = wl + (8 * h + qq) * SG_STRIDE + (16 * blk + 4 * p) * 2;
    const float* bsg = A.sgb + (size_t)(A.layer * 8 + g) * 128;
    const int colg = g * 128 + 32 * db;
    u32x2 uu[4][4]; float bias[4];
#pragma unroll
    for (int ib = 0; ib < 4; ++ib) { const int i = 32 * ib + r32; bias[ib] = bsg[i];
        const bf16_t* up = A.U + (row0 + i) * AW + colg + 4 * hi;
#pragma unroll
        for (int rg = 0; rg < 4; ++rg) uu[ib][rg] = *(const u32x2*)(up + 8 * rg); }
    { const int ch = lane & 3; float gam[8], bet[8];
      const float4 g0 = *(const float4*)(A.lng + (size_t)A.layer * AW + colg + 8 * ch), g1 = *(const float4*)(A.lng + (size_t)A.layer * AW + colg + 8 * ch + 4);
      const float4 b0 = *(const float4*)(A.lnb + (size_t)A.layer * AW + colg + 8 * ch), b1 = *(const float4*)(A.lnb + (size_t)A.layer * AW + colg + 8 * ch + 4);
      gam[0] = g0.x; gam[1] = g0.y; gam[2] = g0.z; gam[3] = g0.w; gam[4] = g1.x; gam[5] = g1.y; gam[6] = g1.z; gam[7] = g1.w;
      bet[0] = b0.x; bet[1] = b0.y; bet[2] = b0.z; bet[3] = b0.w; bet[4] = b1.x; bet[5] = b1.y; bet[6] = b1.z; bet[7] = b1.w;
      u32x4 xr[8];
#pragma unroll
      for (int i = 0; i < 8; ++i) xr[i] = *(const u32x4*)(A.VG + (row0 + (lane >> 2) + 16 * i) * AW + colg + 8 * ch);
#pragma unroll
      for (int i = 0; i < 8; ++i) { const int row = (lane >> 2) + 16 * i; const u32x4 x = xr[i];
          const float m_ = mu[row], r_ = rsd[row];
          float v[8] = {bflo(x.x), bfhi(x.x), bflo(x.y), bfhi(x.y), bflo(x.z), bfhi(x.z), bflo(x.w), bfhi(x.w)};
#pragma unroll
          for (int e = 0; e < 8; ++e) v[e] = (v[e] - m_) * r_ * gam[e] + bet[e];
          u32x4 w; w.x = cvtpk(v[0], v[1]); w.y = cvtpk(v[2], v[3]); w.z = cvtpk(v[4], v[5]); w.w = cvtpk(v[6], v[7]);
          *(LAS u32x4*)(wl + row * SG_STRIDE + ch * 16) = w; } }
    bf16x8 tf[8];
#pragma unroll
    for (int ks = 0; ks < 8; ++ks) tf[ks] = cat8(tr4(tb + (16 * ks) * SG_STRIDE), tr4(tb + (16 * ks + 4) * SG_STRIDE));
#pragma unroll
    for (int ib = 0; ib < 4; ++ib) {
        if (ib + 2 < 4) {
#pragma unroll
            for (int ks = 0; ks < 8; ++ks) w[ib + 2][ks] = *(const bf16x8*)(wg + (size_t)(32 * (ib + 2)) * 128 + 16 * ks); }
        const int i = 32 * ib + r32;
        bf16_t* yp = A.YAB + (row0 + i) * 2048 + colg + 4 * hi;
        f32x16 acc;
#pragma unroll
        for (int rr = 0; rr < 16; ++rr) acc[rr] = 0.f;
#pragma unroll
        for (int ks = 0; ks < 8; ++ks) acc = __builtin_amdgcn_mfma_f32_32x32x16_bf16(tf[ks], w[ib][ks], acc, 0, 0, 0);
#pragma unroll
        for (int rg = 0; rg < 4; ++rg) {
            u32x2 o; o.x = cvtpk(bflo(uu[ib][rg].x) * (acc[4 * rg] + bias[ib]), bfhi(uu[ib][rg].x) * (acc[4 * rg + 1] + bias[ib]));
            o.y = cvtpk(bflo(uu[ib][rg].y) * (acc[4 * rg + 2] + bias[ib]), bfhi(uu[ib][rg].y) * (acc[4 * rg + 3] + bias[ib]));
            *(u32x2*)(yp + 8 * rg) = o; }
    }
}

__device__ __forceinline__ void mix_phase(const MixArgs& A, LAS unsigned char* lds, LAS unsigned* qctr, int vcu, int G, int tid, int wave, int lane, int sel = 7) {
    asm volatile("" : "+v"(lane), "+v"(tid));
    LAS unsigned char* wl = lds + wave * WLDS;
    int it = 0;
    for (int vw = vcu; vw < 256; vw += G, ++it) {
        if (sel & 4) ctx_wg_phase(A, lds, vw, tid, wave, lane, G != 256);
        const int nsgu = ((vw & 1) ? 2 : 3) * 4, sbase = 5 * (vw >> 1) + ((vw & 1) ? 3 : 0), ntot = 4 + nsgu;
        for (;;) {
            unsigned idx = 0;
            if (lane == 0) idx = __hip_atomic_fetch_add(qctr + it, 1u, __ATOMIC_RELAXED, __HIP_MEMORY_SCOPE_WORKGROUP);
            idx = (unsigned)__builtin_amdgcn_readfirstlane((int)idx);
            if ((int)idx >= ntot) break;
            if (idx < 4u) { if (sel & 1) smp_unit(A, 4 * vw + (int)idx, wl, lane); }
            else { if (sel & 2) sgu_unit(A, sbase + (((int)idx - 4) >> 2), ((int)idx - 4) & 3, wl, lane); }
        }
        __syncthreads();
    }
}
}

#define XB_TMO      128
#define XB_XCNT(j)  (256  + 64 * (j))
#define XB_XSUB(j)  (1280 + 64 * (j))
#define XB_XGEN(j)  (2304 + 64 * (j))
#define XB_TOP      3328
#define XB_TOPGEN   3392
#define XCD_BAR_WORDS 3456
#define XB_SPIN_CAP (1u << 18)

__device__ __forceinline__ unsigned xb_ld(unsigned* p)              { return __hip_atomic_load(p, __ATOMIC_RELAXED, __HIP_MEMORY_SCOPE_AGENT); }
__device__ __forceinline__ unsigned xb_add(unsigned* p, unsigned v) { return __hip_atomic_fetch_add(p, v, __ATOMIC_RELAXED, __HIP_MEMORY_SCOPE_AGENT); }
__device__ __forceinline__ unsigned xb_xcc_id() { return (unsigned)__builtin_amdgcn_s_getreg((3 << 11) | 20) & 0xFu; }
#define XB_SPIN(cond, bar) do { unsigned _sp = 0; while (cond) { __builtin_amdgcn_s_sleep(1); \
    if ((++_sp & 255u) == 0u) { if (xb_ld(&(bar)[XB_TMO])) break; if (_sp > XB_SPIN_CAP) { atomicAdd(&(bar)[XB_TMO], 1u); break; } } } } while (0)

struct XcdBarrier { unsigned* bar; unsigned x; volatile LAS unsigned* st; };

__device__ __forceinline__ XcdBarrier xcd_barrier_post(unsigned* bar, volatile LAS unsigned* st) {
    XcdBarrier b; b.bar = bar; b.x = xb_xcc_id(); b.st = st;
    if (threadIdx.x == 0) (void)xb_add(&bar[XB_XCNT(b.x)], 1u);
    return b;
}
__device__ __forceinline__ void xcd_barrier_complete(unsigned* bar, unsigned x, unsigned& nloc, unsigned& nx) {
    const unsigned G = gridDim.x * gridDim.y * gridDim.z;
    unsigned sum, cnt, mine, sp = 0u;
    for (;;) {
        sum = 0u; cnt = 0u; mine = 0u;
#pragma unroll
        for (unsigned j = 0; j < 16; ++j) { const unsigned c = xb_ld(&bar[XB_XCNT(j)]); sum += c; cnt += (c > 0u) ? 1u : 0u; mine = (j == x) ? c : mine; }
        if (sum == G) break;
        __builtin_amdgcn_s_sleep(1);
        if ((++sp & 255u) == 0u) { if (xb_ld(&bar[XB_TMO])) break; if (sp > XB_SPIN_CAP) { atomicAdd(&bar[XB_TMO], 1u); break; } }
    }
    nloc = mine > 0u ? mine : 1u; nx = cnt > 0u ? cnt : 1u;
}
__device__ __forceinline__ void xcd_barrier(const XcdBarrier& b) {
    asm volatile("s_waitcnt vmcnt(0)" ::: "memory");
    __syncthreads();
    if (threadIdx.x == 0) {
        unsigned* bar = b.bar;
        __builtin_amdgcn_s_waitcnt(0);
        unsigned nloc = b.st[0], nx = b.st[1];
        if (nloc == 0u) { xcd_barrier_complete(bar, b.x, nloc, nx); b.st[0] = nloc; b.st[1] = nx; }
        const unsigned old = xb_add(&bar[XB_XSUB(b.x)], 1u);
        const unsigned gen = old / nloc;
        if (old + 1u == (gen + 1u) * nloc) {
            __builtin_amdgcn_fence(__ATOMIC_RELEASE, "agent");
            asm volatile("s_waitcnt vmcnt(0)" ::: "memory");
            const unsigned og = xb_add(&bar[XB_TOP], 1u);
            const unsigned tg = og / nx;
            if (og + 1u == (tg + 1u) * nx) xb_add(&bar[XB_TOPGEN], 1u);
            else XB_SPIN(xb_ld(&bar[XB_TOPGEN]) == tg, bar);
            __builtin_amdgcn_fence(__ATOMIC_ACQUIRE, "agent");
            xb_add(&bar[XB_XGEN(b.x)], 1u);
            asm volatile("s_waitcnt vmcnt(0)" ::: "memory");
        } else {
            XB_SPIN(xb_ld(&bar[XB_XGEN(b.x)]) == gen, bar);
            __builtin_amdgcn_fence(__ATOMIC_ACQUIRE, "agent");
            asm volatile("s_waitcnt vmcnt(0)" ::: "memory");
        }
    }
    __syncthreads();
}

constexpr int I_IN = (D / 64) * (NIN / 32), I_PA = (AW / 64) * (D / 32), I_OUT = (D / 64) * (D / 32), I_F1 = (D / 64) * (DFF / 32), I_F2 = (DFF / 64) * (D / 32);
constexpr int I_LAYER = I_IN + 2 * I_PA + I_OUT + I_F1 + I_F2;
constexpr int I_SPLITA = 10112;
typedef unsigned mix_u32x4 __attribute__((ext_vector_type(4)));
struct ConvDesc { const float* src; bf16_t* dst; int N, ldo; };
__device__ __forceinline__ ConvDesc conv_desc(const Params& P, int l, int r) {
    unsigned char* ws = P.ws; const float* W; bf16_t* WT; int N, ldo, koff = 0, nbw;
    if (r < I_IN) { W = P.w_in + (size_t)l * D * NIN; N = NIN; WT = (bf16_t*)(ws + WS_WIN) + (size_t)l * NIN * D; ldo = D; nbw = NIN / 32; }
    else if ((r -= I_IN) < I_PA) { W = P.w_pa + (size_t)l * AW * D; N = D; WT = (bf16_t*)(ws + WS_WPAB) + (size_t)l * D * 2048; ldo = 2048; nbw = D / 32; }
    else if ((r -= I_PA) < I_PA) { W = P.w_pb + (size_t)l * NAW * D; N = D; WT = (bf16_t*)(ws + WS_WPAB) + (size_t)l * D * 2048; ldo = 2048; koff = 1024; nbw = D / 32; }
    else if ((r -= I_PA) < I_OUT) { W = P.w_out + (size_t)l * D * D; N = D; WT = (bf16_t*)(ws + WS_WOUT) + (size_t)l * D * D; ldo = D; nbw = D / 32; }
    else if ((r -= I_OUT) < I_F1) { W = P.w_ff1 + (size_t)l * D * DFF; N = DFF; WT = (bf16_t*)(ws + WS_WFF1) + (size_t)l * DFF * D; ldo = D; nbw = DFF / 32; }
    else { r -= I_F1; W = P.w_ff2 + (size_t)l * DFF * D; N = D; WT = (bf16_t*)(ws + WS_WFF2) + (size_t)l * D * DFF; ldo = DFF; nbw = D / 32; }
    const int kb = r / nbw, nb = r - kb * nbw;
    int nd = 32 * nb;
    if (N == NIN && nd >= 5120) { const int gB = nd >= 7168, g = nd - (gB ? 7168 : 5120); nd = 5120 + 256 * (g >> 7) + 128 * gB + (g & 127); }
    ConvDesc d; d.src = W + (size_t)(64 * kb) * N + 32 * nb; d.dst = WT + (size_t)nd * ldo + koff + 64 * kb; d.N = N; d.ldo = ldo; return d;
}
__device__ __forceinline__ void conv_load(const ConvDesc& d, mix::f32x4 (&wv)[8], int lane) {
    const float* p = d.src + (size_t)(lane >> 3) * d.N + 4 * (lane & 7);
#pragma unroll
    for (int i = 0; i < 8; ++i) wv[i] = __builtin_nontemporal_load((const mix::f32x4*)(p + (size_t)(8 * i) * d.N));
}
__device__ __forceinline__ void conv_store(const ConvDesc& d, const mix::f32x4 (&wv)[8], LAS float* scr, int lane) {
#pragma unroll
    for (int i = 0; i < 8; ++i) { LAS float* q = scr + (8 * i + (lane >> 3)) * 33 + 4 * (lane & 7); const mix::f32x4 t = wv[i]; q[0] = t[0]; q[1] = t[1]; q[2] = t[2]; q[3] = t[3]; }
    asm volatile("s_waitcnt lgkmcnt(0)" ::: "memory");
    const int c = lane & 7;
#pragma unroll
    for (int j = 0; j < 4; ++j) { const int n = (lane >> 3) + 8 * j; const LAS float* sp = scr + (8 * c) * 33 + n;
        uint4 o; o.x = pk2(sp[0 * 33], sp[1 * 33]); o.y = pk2(sp[2 * 33], sp[3 * 33]); o.z = pk2(sp[4 * 33], sp[5 * 33]); o.w = pk2(sp[6 * 33], sp[7 * 33]);
        __builtin_nontemporal_store((mix_u32x4){o.x, o.y, o.z, o.w}, (mix_u32x4*)(d.dst + (size_t)n * d.ldo + 8 * c)); }
    asm volatile("s_waitcnt lgkmcnt(0)" ::: "memory");
}
__device__ __forceinline__ void conv_stream(const Params& P, int l, int first, int end, int step, LAS float* scr, int lane) {
    asm volatile("" : "+v"(lane));
    if (first >= end) return;
    mix::f32x4 w0[8], w1[8], w2[8], w3[8];
    ConvDesc d0 = conv_desc(P, l, first), d1 = d0, d2 = d0, d3 = d0;
    conv_load(d0, w0, lane);
    if (first + step < end) { d1 = conv_desc(P, l, first + step); conv_load(d1, w1, lane); }
    if (first + 2 * step < end) { d2 = conv_desc(P, l, first + 2 * step); conv_load(d2, w2, lane); }
    for (int r = first; ; r += 4 * step) {
        if (r + 3 * step < end) { d3 = conv_desc(P, l, r + 3 * step); conv_load(d3, w3, lane); }
        conv_store(d0, w0, scr, lane);
        if (r + step >= end) break;
        if (r + 4 * step < end) { d0 = conv_desc(P, l, r + 4 * step); conv_load(d0, w0, lane); }
        conv_store(d1, w1, scr, lane);
        if (r + 2 * step >= end) break;
        if (r + 5 * step < end) { d1 = conv_desc(P, l, r + 5 * step); conv_load(d1, w1, lane); }
        conv_store(d2, w2, scr, lane);
        if (r + 3 * step >= end) break;
        if (r + 6 * step < end) { d2 = conv_desc(P, l, r + 6 * step); conv_load(d2, w2, lane); }
        conv_store(d3, w3, scr, lane);
        if (r + 4 * step >= end) break;
    }
}
__device__ __forceinline__ void cvt_flat(const float* src, bf16_t* dst, size_t n, size_t gtid, size_t gthreads) {
    for (size_t i = gtid * 8; i < n; i += gthreads * 32) {
        float4 a[4], b[4];
#pragma unroll
        for (int u = 0; u < 4; ++u) { const size_t j = i + (size_t)u * gthreads * 8; if (j < n) { a[u] = *(const float4*)(src + j); b[u] = *(const float4*)(src + j + 4); } }
#pragma unroll
        for (int u = 0; u < 4; ++u) { const size_t j = i + (size_t)u * gthreads * 8;
            if (j < n) { uint4 o; o.x = pk2(a[u].x, a[u].y); o.y = pk2(a[u].z, a[u].w); o.z = pk2(b[u].x, b[u].y); o.w = pk2(b[u].z, b[u].w); *(uint4*)(dst + j) = o; } } }
}

constexpr int N_STATE_ITEMS = CB * NH * 2 * 4;
__device__ __forceinline__ void state_load(const unsigned char* ws, int it, int lane, mix::u32x2 (&x)[16]) {
    const int piece = it & 3, kv = (it >> 2) & 1, bh = it >> 3, b = bh >> 4, h = bh & 15;
    const bf16_t* src = (const bf16_t*)(ws + (kv ? WS_V : WS_K)) + ((size_t)b * CS + 64 * piece) * NAW + h * HD;
    const unsigned lo = (unsigned)((lane >> 4) * NAW + (lane & 15) * 4) * 2u;
#pragma unroll
    for (int i = 0; i < 16; ++i) x[i] = __builtin_nontemporal_load((const mix::u32x2*)((const char*)src + (size_t)(4 * i) * NAW * 2 + lo));
}
__device__ __forceinline__ void state_store(float* out, int layer, int it, int lane, const mix::u32x2 (&x)[16]) {
    const int piece = it & 3, kv = (it >> 2) & 1, bh = it >> 3, b = bh >> 4, h = bh & 15;
    float* dst = out + (kv ? OUT_V : OUT_K) + (((size_t)b * NL + layer) * NH + h) * (size_t)(CS * HD) + (size_t)(64 * piece) * HD;
    const unsigned lo = (unsigned)((lane >> 4) * HD + (lane & 15) * 4) * 4u;
#pragma unroll
    for (int i = 0; i < 16; ++i) { const mix::u32x2 t = x[i];
        __builtin_nontemporal_store((mix::f32x4){bflo(t.x), bfhi(t.x), bflo(t.y), bfhi(t.y)}, (mix::f32x4*)((char*)dst + (size_t)(4 * i) * HD * 4 + lo)); }
}
__device__ __forceinline__ void state_stream(const Params& P, int layer, int first, int step, int lane) {
    asm volatile("" : "+v"(lane));
    constexpr int N = N_STATE_ITEMS;
    if (first >= N) return;
    mix::u32x2 x0[16], x1[16], x2[16], x3[16];
    state_load(P.ws, first, lane, x0);
    if (first + step < N) state_load(P.ws, first + step, lane, x1);
    if (first + 2 * step < N) state_load(P.ws, first + 2 * step, lane, x2);
    for (int r = first; ; r += 4 * step) {
        if (r + 3 * step < N) state_load(P.ws, r + 3 * step, lane, x3);
        state_store(P.out, layer, r, lane, x0);
        if (r + step >= N) break;
        if (r + 4 * step < N) state_load(P.ws, r + 4 * step, lane, x0);
        state_store(P.out, layer, r + step, lane, x1);
        if (r + 2 * step >= N) break;
        if (r + 5 * step < N) state_load(P.ws, r + 5 * step, lane, x1);
        state_store(P.out, layer, r + 2 * step, lane, x2);
        if (r + 3 * step >= N) break;
        if (r + 6 * step < N) state_load(P.ws, r + 6 * step, lane, x2);
        state_store(P.out, layer, r + 3 * step, lane, x3);
        if (r + 4 * step >= N) break;
    }
}


__device__ __forceinline__ void prologue_phase(const Params& P, LAS unsigned char* lds, int vcu, int G, int tid, int wave, int lane) {
    asm volatile("" : "+v"(lane), "+v"(tid));
    unsigned char* ws = P.ws;
    {
        LAS float* sv = (LAS float*)lds;
        LAS float* red = (LAS float*)(lds + 3 * D * 4);
#pragma unroll
        for (int q = 0; q < D / NTHREADS; ++q) { const int k = tid + q * NTHREADS; const float a = P.c_ctx[k], b = P.c[k], d = P.c[D + k];
            sv[k] = a / (1.f + __expf(-a)); sv[D + k] = b / (1.f + __expf(-b)); sv[2 * D + k] = d / (1.f + __expf(-d)); }
        __syncthreads();
        float* mod = (float*)(ws + WS_MOD);
        const int cg = lane & 15, ksub = lane >> 4;
        constexpr int NU = NL * (6 * D / 64);
        const int nq = vcu < NU ? 8 * ((NU - 1 - vcu) / G + 1) : 0;
        unsigned loff = (unsigned)(ksub * (6 * D) + 4 * cg) * 4u; asm volatile("" : "+v"(loff));
        auto cbase = [&](int q) -> const char* { const int unit = vcu + G * (q >> 3), c = q & 7; const int l_ = unit / (6 * D / 64), n0_ = (unit % (6 * D / 64)) * 64;
            return (const char*)(P.w_mod + (size_t)l_ * D * (6 * D) + (size_t)(256 * wave + 32 * c) * (6 * D) + n0_); };
        mix::f32x4 x[8], a0 = {0.f, 0.f, 0.f, 0.f}, a1 = a0, a2 = a0;
        if (nq > 0) { const char* b0 = cbase(0);
#pragma unroll
            for (int j = 0; j < 8; ++j) x[j] = __builtin_nontemporal_load((const mix::f32x4*)(b0 + (size_t)(4 * j) * (6 * D) * 4 + loff)); }
        for (int q = 0; q < nq; ++q) {
            const int unit = vcu + G * (q >> 3), c = q & 7;
            const int l = unit / (6 * D / 64), n0 = (unit % (6 * D / 64)) * 64;
            const char* nb = cbase(q + 1 < nq ? q + 1 : q);
            const LAS float* svk = sv + 256 * wave + 32 * c + ksub;
#pragma unroll
            for (int j = 0; j < 8; ++j) { const mix::f32x4 xv = x[j];
                x[j] = __builtin_nontemporal_load((const mix::f32x4*)(nb + (size_t)(4 * j) * (6 * D) * 4 + loff));
                const float s0 = svk[4 * j], s1 = svk[D + 4 * j], s2 = svk[2 * D + 4 * j];
                a0 += s0 * xv; a1 += s1 * xv; a2 += s2 * xv; }
            if (c != 7) continue;
            float acc[3][4];
#pragma unroll
            for (int e = 0; e < 4; ++e) { acc[0][e] = a0[e]; acc[1][e] = a1[e]; acc[2][e] = a2[e]; }
            a0 = (mix::f32x4){0.f, 0.f, 0.f, 0.f}; a1 = a0; a2 = a0;
#pragma unroll
            for (int v = 0; v < 3; ++v)
#pragma unroll
                for (int e = 0; e < 4; ++e) { float a = acc[v][e]; a += __shfl_xor(a, 16); a += __shfl_xor(a, 32); acc[v][e] = a; }
            if (lane < 16) {
#pragma unroll
                for (int v = 0; v < 3; ++v)
#pragma unroll
                    for (int e = 0; e < 4; ++e) red[(wave * 3 + v) * 64 + 4 * cg + e] = acc[v][e]; }
            __syncthreads();
            if (tid < 192) { const int v = tid >> 6, n = tid & 63; float s = P.b_mod[(size_t)l * 6 * D + n0 + n];
#pragma unroll
                for (int w = 0; w < 8; ++w) s += red[(w * 3 + v) * 64 + n];
                mod[((size_t)l * 3 + v) * 6 * D + n0 + n] = s; }
            __syncthreads();
        }
    }
    {
        LAS float* scr = (LAS float*)(lds + wave * WLDS);
        const int gw = vcu * NWAVES + wave, NGW = G * NWAVES;
        if (G == 256) conv_stream(P, 0, gw, I_IN, NGW, scr, lane);
        else for (int l = 0; l < NL; ++l) conv_stream(P, l, gw, I_LAYER, NGW, scr, lane);
    }
    {
        const size_t gtid = (size_t)vcu * NTHREADS + tid, gth = (size_t)G * NTHREADS;
        cvt_flat(P.sgu_w, (bf16_t*)(ws + WS_WS), (size_t)NL * 8 * 128 * 128, gtid, gth);
        if (G != 256) {
        cvt_flat(P.cache_k, (bf16_t*)(ws + WS_CK), (size_t)SBT * NL * NH * PAST * HD, gtid, gth);
        cvt_flat(P.cache_v, (bf16_t*)(ws + WS_CV), (size_t)SBT * NL * NH * PAST * HD, gtid, gth); }
        if (gtid < 64 * 16) { const int pos = (int)gtid >> 4, f = (int)gtid & 15; const float freq = powf(10000.f, -(float)f / 16.f), ang = (float)pos * freq;
            ((float2*)(ws + WS_ROPE))[gtid] = make_float2(cosf(ang), sinf(ang)); }
    }
}

__device__ __forceinline__ void block_rowsum8(float (&v)[8], LAS float* buf, int wave, int lane, float (&tot)[8]) {
#pragma unroll
    for (int i = 0; i < 4; ++i) { const float keep = (lane & 4) ? v[i + 4] : v[i], send = (lane & 4) ? v[i] : v[i + 4]; v[i] = keep + __shfl_xor(send, 4); }
#pragma unroll
    for (int i = 0; i < 2; ++i) { const float keep = (lane & 2) ? v[i + 2] : v[i], send = (lane & 2) ? v[i] : v[i + 2]; v[i] = keep + __shfl_xor(send, 2); }
    { const float keep = (lane & 1) ? v[1] : v[0], send = (lane & 1) ? v[0] : v[1]; v[0] = keep + __shfl_xor(send, 1); }
    float t = v[0];
    t += __shfl_xor(t, 8); t += __shfl_xor(t, 16); t += __shfl_xor(t, 32);
    if (lane < 8) buf[wave * 8 + lane] = t;
    __syncthreads();
    float u = buf[lane];
    u += __shfl_xor(u, 8); u += __shfl_xor(u, 16); u += __shfl_xor(u, 32);
#pragma unroll
    for (int r = 0; r < 8; ++r) tot[r] = __builtin_bit_cast(float, __builtin_amdgcn_readlane(__builtin_bit_cast(int, u), r));
}
__device__ __forceinline__ void norm_phase(const Params& P, LAS unsigned char* lds, bool first, bool last, const bf16_t* y0, size_t ydelta, bool tail4, const float* modl, int gate_idx, const float* gpost,
                                           const float* modn, int pre_idx, const float* gpre, bf16_t* hout, int vcu, int G, int wave, int lane) {
    asm volatile("" : "+v"(lane));
    LAS float* red = (LAS float*)lds;
    const int col = 256 * wave + 4 * lane;
    const bool hasy = y0 != nullptr;
    int it = 0;
    bf16_t* XB = (bf16_t*)(P.ws + WS_XB);
    float4 xf[8]; uint2 xr[8], yr[8];
    auto issue = [&](int bb, float4 (&xf_)[8], uint2 (&xr_)[8], uint2 (&yr_)[8]) {
        const int r0 = 8 * bb;
        if (first) { const float* xb = r0 < NCTX ? P.x_prompt + (size_t)r0 * D : P.x_sample + (size_t)(r0 - NCTX) * D;
#pragma unroll
            for (int r = 0; r < 8; ++r) xf_[r] = *(const float4*)(xb + (size_t)r * D + col);
        } else {
#pragma unroll
            for (int r = 0; r < 8; ++r) xr_[r] = *(const uint2*)(XB + (size_t)(r0 + r) * D + col); }
        if (hasy) {
#pragma unroll
            for (int r = 0; r < 8; ++r) yr_[r] = *(const uint2*)(y0 + (size_t)(r0 + r) * D + col); }
    };
    if (vcu < M / 8) issue(vcu, xf, xr, yr);
    int cvc = -1; float4 GPv = make_float4(0.f, 0.f, 0.f, 0.f), Av = GPv, Bv = GPv;
    for (int b = vcu; b < M / 8; b += G, ++it) {
        const int row0 = 8 * b; const int cv = row0 < NCTX ? 0 : 1 + (row0 - NCTX) / SS;
        const int nparts = (tail4 && row0 >= NCTX) ? 4 : 1;
        if (cv != cvc) {
            cvc = cv;
            if (hasy) { const float4 g = *(const float4*)(modl + (size_t)cv * 6 * D + (size_t)gate_idx * D + col), p = *(const float4*)(gpost + col);
                GPv = make_float4(g.x * p.x, g.y * p.y, g.z * p.z, g.w * p.w); }
            if (hout) { const float* sh = modn + (size_t)cv * 6 * D + (size_t)pre_idx * D + col;
                const float4 gp = *(const float4*)(gpre + col), a = *(const float4*)sh, sc = *(const float4*)(sh + D);
                Av = make_float4(gp.x * (1.f + sc.x), gp.y * (1.f + sc.y), gp.z * (1.f + sc.z), gp.w * (1.f + sc.w)); Bv = a; }
        }
        const bool more = b + G < M / 8;
        float4 nxf[8]; uint2 nxr[8], nyr[8];
        if (more) issue(b + G, nxf, nxr, nyr);
        float4 xv[8]; float yv[8][4];
        if (first) {
#pragma unroll
            for (int r = 0; r < 8; ++r) xv[r] = xf[r];
        } else {
#pragma unroll
            for (int r = 0; r < 8; ++r) xv[r] = make_float4(bflo(xr[r].x), bfhi(xr[r].x), bflo(xr[r].y), bfhi(xr[r].y)); }
        if (hasy) {
#pragma unroll
            for (int r = 0; r < 8; ++r) { const uint2 t = yr[r];
                yv[r][0] = bflo(t.x); yv[r][1] = bfhi(t.x); yv[r][2] = bflo(t.y); yv[r][3] = bfhi(t.y); }
            if (nparts > 1) {
#pragma unroll
                for (int q = 1; q < 4; ++q)
#pragma unroll
                    for (int r = 0; r < 8; ++r) { const uint2 t = *(const uint2*)(y0 + (size_t)q * ydelta + (size_t)(row0 + r) * D + col);
                        yv[r][0] += bflo(t.x); yv[r][1] += bfhi(t.x); yv[r][2] += bflo(t.y); yv[r][3] += bfhi(t.y); } }
        }
        if (hasy) {
            float ps[8], tot[8];
#pragma unroll
            for (int r = 0; r < 8; ++r) ps[r] = yv[r][0] * yv[r][0] + yv[r][1] * yv[r][1] + yv[r][2] * yv[r][2] + yv[r][3] * yv[r][3];
            block_rowsum8(ps, red + ((it & 1) * 2 + 0) * 64, wave, lane, tot);
#pragma unroll
            for (int r = 0; r < 8; ++r) { const float rr = rsqrtf(tot[r] * (1.f / D) + EPS);
                xv[r].x += GPv.x * (yv[r][0] * rr); xv[r].y += GPv.y * (yv[r][1] * rr); xv[r].z += GPv.z * (yv[r][2] * rr); xv[r].w += GPv.w * (yv[r][3] * rr); }
        }
        if (last) { float* xo = P.out + OUT_X + (size_t)row0 * D + col;
#pragma unroll
            for (int r = 0; r < 8; ++r) *(float4*)(xo + (size_t)r * D) = xv[r];
        } else {
#pragma unroll
            for (int r = 0; r < 8; ++r) { uint2 o; o.x = pk2(xv[r].x, xv[r].y); o.y = pk2(xv[r].z, xv[r].w); *(uint2*)(XB + (size_t)(row0 + r) * D + col) = o; } }
        if (hout) {
            float ps[8], tot[8];
#pragma unroll
            for (int r = 0; r < 8; ++r) ps[r] = xv[r].x * xv[r].x + xv[r].y * xv[r].y + xv[r].z * xv[r].z + xv[r].w * xv[r].w;
            block_rowsum8(ps, red + ((it & 1) * 2 + 1) * 64, wave, lane, tot);
#pragma unroll
            for (int r = 0; r < 8; ++r) { const float rr = rsqrtf(tot[r] * (1.f / D) + EPS);
                uint2 o; o.x = pk2(xv[r].x * rr * Av.x + Bv.x, xv[r].y * rr * Av.y + Bv.y); o.y = pk2(xv[r].z * rr * Av.z + Bv.z, xv[r].w * rr * Av.w + Bv.w);
                *(uint2*)(hout + (size_t)(row0 + r) * D + col) = o; }
        }
        if (more) {
#pragma unroll
            for (int r = 0; r < 8; ++r) { if (first) xf[r] = nxf[r]; else xr[r] = nxr[r]; if (hasy) yr[r] = nyr[r]; } }
    }
    __syncthreads();
}

__global__ void __launch_bounds__(NTHREADS, 2) mk_fwd(Params P) {
    extern __shared__ __attribute__((aligned(16))) unsigned char lds_raw[];
    LAS unsigned char* lds = (LAS unsigned char*)lds_raw;
    volatile LAS unsigned* MISC = (volatile LAS unsigned*)(lds + MISC_OFF);
    const int tid = threadIdx.x, lane = tid & 63, wave = __builtin_amdgcn_readfirstlane(tid >> 6);
    const int G = gridDim.x; const int bx = blockIdx.x; const int vcu = (G % 8 == 0) ? (bx % 8) * (G / 8) + bx / 8 : bx;
    unsigned char* ws = P.ws;
    for (int u = tid; u < (LDS_BYTES - MISC_OFF) / 4; u += NTHREADS) MISC[u] = 0u;
    __syncthreads();
    const int lo = P.ph_lo, hi = P.ph_hi;
    XcdBarrier bar; bar.bar = (unsigned*)(ws + WS_CTL) + CW_BAR; bar.x = 0; bar.st = nullptr;
    if (hi - lo > 1) bar = xcd_barrier_post((unsigned*)(ws + WS_CTL) + CW_BAR, MISC + 8);
#define IN(k) (lo <= (k) && (k) < hi)
#define SEAM(k) do { if (IN(k) && IN((k) + 1)) { xcd_barrier(bar); if (PROBE_DUP == 99) xcd_barrier(bar); } } while (0)

    float* mod = (float*)(ws + WS_MOD);
    bf16_t* H = (bf16_t*)(ws + WS_H); bf16_t* U = (bf16_t*)(ws + WS_U); bf16_t* VG = (bf16_t*)(ws + WS_VG); bf16_t* Q = (bf16_t*)(ws + WS_Q); bf16_t* Kb = (bf16_t*)(ws + WS_K); bf16_t* Vb = (bf16_t*)(ws + WS_V);
    bf16_t* SA = (bf16_t*)(ws + WS_SA); bf16_t* SB = (bf16_t*)(ws + WS_SB); bf16_t* YAB = (bf16_t*)(ws + WS_YAB); bf16_t* MG = (bf16_t*)(ws + WS_MG);
    bf16_t* O = (bf16_t*)(ws + WS_O); bf16_t* F1 = (bf16_t*)(ws + WS_F1);

    if ((PH_MASK & 1) && IN(0)) { prologue_phase(P, lds, vcu, G, tid, wave, lane); if (PROBE_DUP == 0) { __syncthreads(); prologue_phase(P, lds, vcu, G, tid, wave, lane); } } SEAM(0);
    if ((PH_MASK & 2) && IN(1)) { norm_phase(P, lds, true, false, nullptr, 0, false, mod, 0, nullptr, mod, 0, P.g_pre_mix, H, vcu, G, wave, lane); } SEAM(1);

    for (int l = 0; l < NL; ++l) {
        const int pb = 2 + 8 * l;
        const float* modl = mod + (size_t)l * 3 * 6 * D;
        if ((PH_MASK & 4) && IN(pb + 0)) {
            pg8::Gemm g{H, (const bf16_t*)(ws + WS_WIN) + (size_t)l * NIN * D, D, D, D, M, NIN, 0};
            const bool spec = (G == 256);
            if (!spec || bx < 240) {
            pg8::StaticOrder S; S.init(M, NIN, D, spec ? 240 : G, bx);
            pg8::EpiIn E{U, Q, SA, P.out, (float2*)(ws + WS_STATS), (const float2*)(ws + WS_ROPE), l, 0};
            pg8::gemm_phase<pg8::EpiIn, pg8::StaticOrder, true>(lds, g, S, E);
            } else {
                {
                    int tl = tid; asm volatile("" : "+v"(tl));
                    const size_t n1 = (size_t)NH * PAST * HD, gtid = (size_t)(bx - 240) * NTHREADS + tl, gth = (size_t)16 * NTHREADS;
                    for (int b = 0; b < SBT; ++b) { const size_t off = ((size_t)b * NL + l) * n1;
                        cvt_flat(P.cache_k + off, (bf16_t*)(ws + WS_CK) + off, n1, gtid, gth); cvt_flat(P.cache_v + off, (bf16_t*)(ws + WS_CV) + off, n1, gtid, gth); } }
                conv_stream(P, l, I_IN + (bx - 240) * NWAVES + wave, I_IN + I_SPLITA, 16 * NWAVES, (LAS float*)(lds + wave * WLDS), lane); }
        }
        SEAM(pb + 0);
        if ((PH_MASK & 8) && IN(pb + 1)) {
            mix::MixArgs A{Q, Kb, Vb, (const bf16_t*)(ws + WS_CK), (const bf16_t*)(ws + WS_CV), U, VG, (const bf16_t*)(ws + WS_WS), (const float2*)(ws + WS_STATS),
                           P.na_rpb, P.sgu_ln_g, P.sgu_ln_b, P.sgu_b, YAB, P.out, l};
            mix::mix_phase(A, lds, (LAS unsigned*)(lds + MISC_OFF) + 16 + 8 * l, vcu, G, tid, wave, lane);
            if (PROBE_DUP == 3) mix::mix_phase(A, lds, (LAS unsigned*)(lds + MISC_OFF) + 64 + 8 * l, vcu, G, tid, wave, lane);
            if (PROBE_DUP >= 31 && PROBE_DUP <= 34) mix::mix_phase(A, lds, (LAS unsigned*)(lds + MISC_OFF) + 64 + 8 * l, vcu, G, tid, wave, lane, PROBE_DUP == 31 ? 1 : (PROBE_DUP == 32 ? 2 : (PROBE_DUP == 33 ? 4 : 0)));
        }
        SEAM(pb + 1);
        if ((PH_MASK & 16) && IN(pb + 2)) {
            pg8::Gemm g{YAB, (const bf16_t*)(ws + WS_WPAB) + (size_t)l * D * 2048, 2048, 2048, 2048, M, D, 0};
            const bool spec = (G == 256);
            if (!spec || bx < 160) {
            pg8::StaticOrder S; S.init(M, D, 2048, spec ? 160 : G, bx);
            pg8::EpiMerge E{SA, SB, MG};
            pg8::gemm_phase<pg8::EpiMerge, pg8::StaticOrder, true>(lds, g, S, E);
            } else { conv_stream(P, l, I_IN + I_SPLITA + (bx - 160) * NWAVES + wave, I_LAYER, 96 * NWAVES, (LAS float*)(lds + wave * WLDS), lane);
                if (l + 1 < NL) conv_stream(P, l + 1, (bx - 160) * NWAVES + wave, I_IN, 96 * NWAVES, (LAS float*)(lds + wave * WLDS), lane);
                state_stream(P, l, (bx - 160) * NWAVES + wave, 96 * NWAVES, lane); }
        }
        SEAM(pb + 2);
        if ((PH_MASK & 32) && IN(pb + 3)) {
            pg8::Gemm g{MG, (const bf16_t*)(ws + WS_WOUT) + (size_t)l * D * D, D, D, D, M, D, 0};
            pg8::TailSplit S; S.init(D, G, vcu, bx);
            pg8::EpiPart E{O, (size_t)(WS_O1 - WS_O) / 2, D, 0};
            pg8::gemm_phase<pg8::EpiPart, pg8::TailSplit, true>(lds, g, S, E);
            if (PROBE_DUP == 5) pg8::gemm_phase<pg8::EpiPart, pg8::TailSplit, true>(lds, g, S, E);
        }
        SEAM(pb + 3);
        if ((PH_MASK & 64) && IN(pb + 4)) { norm_phase(P, lds, false, false, O, (size_t)(WS_O1 - WS_O) / 2, G == 256, modl, 2, P.g_post_mix + (size_t)l * D, modl, 3, P.g_pre_ffn + (size_t)l * D, H, vcu, G, wave, lane); }
        SEAM(pb + 4);
        if ((PH_MASK & 128) && IN(pb + 5)) {
            pg8::Gemm g{H, (const bf16_t*)(ws + WS_WFF1) + (size_t)l * DFF * D, D, D, D, M, DFF, 0};
            pg8::StaticOrder S; S.init(M, DFF, D, G, bx);
            pg8::EpiBf16<2> E{F1, DFF, 0};
            pg8::gemm_phase<pg8::EpiBf16<2>, pg8::StaticOrder, true>(lds, g, S, E);
            if (PROBE_DUP == 7) pg8::gemm_phase<pg8::EpiBf16<2>, pg8::StaticOrder, true>(lds, g, S, E);
            if (PROBE_DUP == 40) { pg8::ProbeOrder PS; PS.S = S; PS.mask = -1; pg8::EpiBf16<2> E2{(bf16_t*)(ws + WS_END), DFF, 0}; pg8::gemm_phase<pg8::EpiBf16<2>, pg8::ProbeOrder, true>(lds, g, PS, E2); }
            if (PROBE_DUP == 43) { pg8::ProbeOrder PS; PS.S = S; PS.mask = -1; pg8::EpiFixed E4{(bf16_t*)(ws + WS_END), 0, 0}; pg8::gemm_phase<pg8::EpiFixed, pg8::ProbeOrder, true>(lds, g, PS, E4); }
            if (PROBE_DUP == 42) { pg8::ProbeOrder PS; PS.S = S; PS.mask = -1; pg8::EpiNone E3{0, 0}; pg8::gemm_phase<pg8::EpiNone, pg8::ProbeOrder, true>(lds, g, PS, E3); }
        }
        SEAM(pb + 5);
        if ((PH_MASK & 256) && IN(pb + 6)) {
            pg8::Gemm g{F1, (const bf16_t*)(ws + WS_WFF2) + (size_t)l * D * DFF, DFF, DFF, DFF, M, D, 0};
            pg8::TailSplit S; S.init(DFF, G, vcu, bx);
            pg8::EpiPart E{O, (size_t)(WS_O1 - WS_O) / 2, D, 0};
            pg8::gemm_phase<pg8::EpiPart, pg8::TailSplit, true>(lds, g, S, E);
            if (PROBE_DUP == 8) pg8::gemm_phase<pg8::EpiPart, pg8::TailSplit, true>(lds, g, S, E);
        }
        SEAM(pb + 6);
        if ((PH_MASK & 512) && IN(pb + 7)) {
            const bool lastl = (l == NL - 1);
            norm_phase(P, lds, false, lastl, O, (size_t)(WS_O1 - WS_O) / 2, G == 256, modl, 5, P.g_post_ffn + (size_t)l * D, lastl ? modl : modl + 3 * 6 * D, 0, lastl ? P.g_pre_mix : P.g_pre_mix + (size_t)(l + 1) * D, lastl ? (bf16_t*)nullptr : H, vcu, G, wave, lane);
        }
        SEAM(pb + 7);
    }
#undef IN
#undef SEAM
}
constexpr int N_PHASES = 2 + 8 * NL;

extern "C" void kernel_launch(void* const* d_in, const int* in_sizes, int n_in, void* d_out, int out_size, void* d_ws, size_t ws_size, hipStream_t stream) {
    static int grid = 0;
    if (grid == 0) {
        if (n_in != 23 || ws_size < WS_END + ((PROBE_DUP == 40 || PROBE_DUP == 43) ? 160 * MiB : 0) || (size_t)out_size != OUT_END) { fprintf(stderr, "kernel_launch: unexpected shapes n_in %d ws %zu (need %zu) out %d\n", n_in, ws_size, (size_t)WS_END, out_size); grid = -1; return; }
        int dev = 0, cus = 0, per_cu = 0;
        if (hipGetDevice(&dev) != hipSuccess || hipDeviceGetAttribute(&cus, hipDeviceAttributeMultiprocessorCount, dev) != hipSuccess) { grid = -1; return; }
        if (hipFuncSetAttribute((const void*)mk_fwd, hipFuncAttributeMaxDynamicSharedMemorySize, LDS_BYTES) != hipSuccess) { fprintf(stderr, "kernel_launch: hipFuncSetAttribute failed\n"); grid = -1; return; }
        if (hipOccupancyMaxActiveBlocksPerMultiprocessor(&per_cu, (const void*)mk_fwd, NTHREADS, LDS_BYTES) != hipSuccess || per_cu < 1) { fprintf(stderr, "kernel_launch: occupancy query says %d\n", per_cu); }
        (void)hipGetLastError();
        grid = cus < 256 ? cus : 256;
        while (256 % grid) --grid;
#ifdef FORCE_GRID
        grid = FORCE_GRID;
#endif
    }
    if (grid < 0) return;
    if (hipMemsetAsync((char*)d_ws + WS_CTL, 0, CTL_ZERO_BYTES, stream) != hipSuccess) return;
    Params p{};
    const float** pp = (const float**)&p;
    for (int i = 0; i < 23; ++i) pp[i] = (const float*)d_in[i];
    p.out = (float*)d_out; p.ws = (unsigned char*)d_ws;
#if MK_PER_PHASE
    for (int ph = 0; ph < N_PHASES; ++ph) { p.ph_lo = ph; p.ph_hi = ph + 1; hipLaunchKernelGGL(mk_fwd, dim3(grid), dim3(NTHREADS), LDS_BYTES, stream, p); }
#else
    p.ph_lo = 0; p.ph_hi = N_PHASES;
    hipLaunchKernelGGL(mk_fwd, dim3(grid), dim3(NTHREADS), LDS_BYTES, stream, p);
#endif
}
```

```cpp
#include <hip/hip_runtime.h>
#include <cstdio>
#include <cstdint>

#ifndef PH_MASK
#define PH_MASK 0x3FF
#endif
#ifndef PROBE_DUP
#define PROBE_DUP -1
#endif
#ifndef MK_PER_PHASE
#define MK_PER_PHASE 0
#endif

constexpr int D = 2048, NCTX = 8192, NSMP = 2048, M = NCTX + NSMP, NL = 4;
constexpr int NIN = 9216, AW = 1024, NAW = 1024, DFF = 8192;
constexpr int CB = 32, CS = 256, SBT = 2, SS = 1024, PAST = 512, NH = 16, HD = 64, GW = 64, GROWS = 16;
constexpr size_t OUT_X = 0, OUT_K = (size_t)M * D, OUT_V = OUT_K + (size_t)CB * NL * NH * CS * HD, OUT_END = OUT_V + (size_t)CB * NL * NH * CS * HD;
constexpr float EPS = 1e-6f;
constexpr int NWAVES = 8, NTHREADS = 512;

typedef unsigned short bf16_t;
#define LAS __attribute__((address_space(3)))
#define GAS __attribute__((address_space(1)))

__device__ __forceinline__ unsigned f2bf(float f) { unsigned u = __builtin_bit_cast(unsigned, f); return (u + 0x7fffu + ((u >> 16) & 1u)) >> 16; }
__device__ __forceinline__ float bf2f(unsigned h) { return __builtin_bit_cast(float, h << 16); }
__device__ __forceinline__ float bflo(unsigned w) { return __builtin_bit_cast(float, w << 16); }
__device__ __forceinline__ float bfhi(unsigned w) { return __builtin_bit_cast(float, w & 0xffff0000u); }
__device__ __forceinline__ unsigned pk2(float lo, float hi) { return f2bf(lo) | (f2bf(hi) << 16); }
__device__ __forceinline__ float gelu_tanh(float x) { const float x2 = x * x; const float t = x * __builtin_fmaf(x2, -0.1029432408f, -2.302208198f);
    return x * __builtin_amdgcn_rcpf(1.f + __builtin_amdgcn_exp2f(t)); }
__device__ __forceinline__ float sigmoidf(float x) { return __builtin_amdgcn_rcpf(1.f + __builtin_amdgcn_exp2f(-1.4426950408889634f * x)); }
__device__ __forceinline__ float wave_sum(float v) {
#pragma unroll
    for (int o = 1; o < 64; o <<= 1) v += __shfl_xor(v, o);
    return v;
}

constexpr size_t MiB = 1u << 20;
constexpr size_t WS_CTL = 0, CTL_ZERO_BYTES = 64 * 1024;
constexpr size_t WS_ROPE = 1 * MiB;
constexpr size_t WS_MOD = 2 * MiB;
constexpr size_t WS_WS = 3 * MiB;
constexpr size_t WS_WIN = 4 * MiB;
constexpr size_t WS_WPAB = WS_WIN + 144 * MiB;
constexpr size_t WS_WOUT = WS_WPAB + 32 * MiB;
constexpr size_t WS_WFF1 = WS_WOUT + 32 * MiB;
constexpr size_t WS_WFF2 = WS_WFF1 + 128 * MiB;
constexpr size_t WS_CK = WS_WFF2 + 128 * MiB;
constexpr size_t WS_CV = WS_CK + 8 * MiB;
constexpr size_t WS_STATS = WS_CV + 8 * MiB;
constexpr size_t WS_H = WS_STATS + 2 * MiB;
constexpr size_t WS_U = WS_H + 40 * MiB;
constexpr size_t WS_VG = WS_U + 20 * MiB;
constexpr size_t WS_Q = WS_VG + 20 * MiB;
constexpr size_t WS_K = WS_Q + 20 * MiB;
constexpr size_t WS_V = WS_K + 20 * MiB;
constexpr size_t WS_SA = WS_V + 20 * MiB;
constexpr size_t WS_SB = WS_SA + 40 * MiB;
constexpr size_t WS_YAB = WS_SB + 40 * MiB;
constexpr size_t WS_MG = WS_YAB + 40 * MiB;
constexpr size_t WS_O = WS_MG + 40 * MiB;
constexpr size_t WS_O1 = WS_O + 40 * MiB;
constexpr size_t WS_F1 = WS_O1 + 120 * MiB;
constexpr size_t WS_XB = WS_F1 + 160 * MiB;
constexpr size_t WS_END = WS_XB + 40 * MiB;
static_assert(WS_VG - WS_U == 20 * MiB && WS_K - WS_Q == 20 * MiB && WS_V - WS_K == 20 * MiB && WS_SB - WS_SA == 40 * MiB, "EpiIn picks its destination buffer by arithmetic");
constexpr int CW_BAR = 4096;

constexpr int RING_BYTES = 131072, MISC_OFF = RING_BYTES, LDS_BYTES = RING_BYTES + 1024;
constexpr int WLDS = 16384;

struct Params {
    const float *x_prompt, *x_sample, *cache_k, *cache_v, *c, *c_ctx, *w_mod, *b_mod, *g_pre_mix, *g_post_mix, *g_pre_ffn, *g_post_ffn,
                *w_in, *sgu_ln_g, *sgu_ln_b, *sgu_w, *sgu_b, *na_rpb, *w_pa, *w_pb, *w_out, *w_ff1, *w_ff2;
    float* out; unsigned char* ws; int ph_lo, ph_hi;
};

namespace pg8 {
typedef short bf16x8 __attribute__((ext_vector_type(8)));
typedef float f32x4 __attribute__((ext_vector_type(4)));
typedef float f32x2 __attribute__((ext_vector_type(2)));
typedef unsigned u32x4 __attribute__((ext_vector_type(4)));
constexpr int BM = 256, BK = 64, HALF = 128, HTB = HALF * BK * 2, STAGE_BYTES = 8 * HTB, NXCD = 8, WGM = 8;

__host__ __device__ __forceinline__ int lds_byte(int r, int c) { const int st = (r >> 4) * 2 + (c >> 5), rr = r & 15, cc = c & 31, ob = rr * 64 + cc * 2; return st * 1024 + (ob ^ (((ob >> 9) & 1) << 5)); }
__host__ __device__ __forceinline__ void stage_rc(int b, int& R, int& C) { const int st = b / 1024, sb = b % 1024, swz = sb ^ (((sb >> 9) & 1) << 5); R = (st >> 1) * 16 + swz / 64; C = (st & 1) * 32 + (swz % 64) / 2; }
__host__ __device__ __forceinline__ int perm32(int rho) { const int n = rho >> 4, i = rho & 15; return 8 * (i >> 2) + 4 * n + (i & 3); }

struct Unit { int pm, pn, k0, nk; };
struct Gemm { const bf16_t* A; const bf16_t* Bt; int lda, ldb, K, Mr, N, pad; };

struct StaticOrder {
    int nM, nN, nwg, G, c, nkt;
    __host__ __device__ void init(int Mr, int N, int K, int G_, int c_) { nM = Mr / BM; nN = N / BM; nwg = nM * nN; G = G_; c = c_; nkt = K / BK; }
    __host__ __device__ bool next(int i, Unit& u) const {
        const long Lx = (long)i * G + c; if (Lx >= nwg) return false;
        int wgid = (int)Lx; { const int q = nwg / NXCD, r = nwg % NXCD, xcd = wgid % NXCD, off = wgid / NXCD; wgid = (xcd < r ? xcd * (q + 1) : r * (q + 1) + (xcd - r) * q) + off; }
        const int nig = WGM * nN, gid = wgid / nig, fm = gid * WGM, gsz = (nM - fm) < WGM ? (nM - fm) : WGM;
        u.pm = fm + ((wgid % nig) % gsz); u.pn = (wgid % nig) / gsz; u.k0 = 0; u.nk = nkt; return true;
    }
};

struct TailSplit {
    StaticOrder S; int c; bool ok;
    __device__ void init(int K, int G, int c_, int bx) { ok = (G == 256); S.init(ok ? NCTX : M, D, K, G, bx); c = c_; }
    __device__ bool next(int i, Unit& u) const {
        Unit a; a.pm = 0; a.pn = 0; a.k0 = 0; a.nk = 2;
        const bool r0 = S.next(i, a);
        const bool tail = ok && (i == 1);
        const int T2 = c >> 2, q = c & 3, nk4 = S.nkt >> 2;
        u.pm = tail ? NCTX / BM + (T2 >> 3) : a.pm; u.pn = tail ? (T2 & 7) : a.pn; u.nk = tail ? nk4 : a.nk; u.k0 = tail ? q * nk4 : a.k0;
        return ok ? (i <= 1 ? (i == 0 ? r0 : true) : false) : r0;
    }
};

__device__ __forceinline__ unsigned cvt_pk_bf16(float lo, float hi) { unsigned r; asm volatile("v_cvt_pk_bf16_f32 %0, %1, %2" : "=v"(r) : "v"(lo), "v"(hi)); return r; }

struct EpiF32 {
    static constexpr bool PERM = false, MIDK = false;
    float* C; int ldc, pad;
    __device__ __forceinline__ void operator()(const f32x4 (&acc)[2][2][4][2], const Unit& u, int wr, int wc, int fr, int fq, int lane) const {
        const int row0 = u.pm * BM + wr * 64 + fr, col0 = u.pn * BM + wc * 32 + 4 * fq;
#pragma unroll
        for (int ai = 0; ai < 2; ++ai)
#pragma unroll
            for (int m = 0; m < 4; ++m) { float* rowp = C + (size_t)(row0 + ai * HALF + m * 16) * ldc + col0;
#pragma unroll
                for (int bj = 0; bj < 2; ++bj)
#pragma unroll
                    for (int n = 0; n < 2; ++n) *(f32x4*)(rowp + bj * HALF + n * 16) = acc[ai][bj][m][n]; }
    }
};
template <int ACT  > struct EpiBf16 {
    static constexpr bool PERM = true, MIDK = false;
    bf16_t* O; int ldc, pad;
    __device__ __forceinline__ void operator()(const f32x4 (&acc)[2][2][4][2], const Unit& u, int wr, int wc, int fr, int fq, int lane) const {
        const int row0 = u.pm * BM + wr * 64 + fr; const int col0 = u.pn * BM + wc * 32 + 8 * fq;
#pragma unroll
        for (int ai = 0; ai < 2; ++ai)
#pragma unroll
            for (int m = 0; m < 4; ++m) { bf16_t* rowp = O + (size_t)(row0 + ai * HALF + m * 16) * ldc + col0;
#pragma unroll
                for (int bj = 0; bj < 2; ++bj) { f32x4 v0 = acc[ai][bj][m][0], v1 = acc[ai][bj][m][1];
                    if (ACT == 2) {
#pragma unroll
                        for (int e = 0; e < 4; ++e) { const float a = fmaxf(v0[e], 0.f), b = fmaxf(v1[e], 0.f); v0[e] = a * a; v1[e] = b * b; } }
                    u32x4 w; w.x = cvt_pk_bf16(v0[0], v0[1]); w.y = cvt_pk_bf16(v0[2], v0[3]); w.z = cvt_pk_bf16(v1[0], v1[1]); w.w = cvt_pk_bf16(v1[2], v1[3]);
                    *(u32x4*)(rowp + bj * HALF) = w; } }
    }
};

struct ProbeOrder {
    StaticOrder S; int mask;
    __device__ bool next(int i, Unit& u) const { Unit a; a.pm = 0; a.pn = 0; a.k0 = 0; a.nk = 2; const bool r = S.next(i, a); u.pm = a.pm & mask; u.pn = a.pn & mask; u.k0 = a.k0; u.nk = a.nk; return r; }
};
struct EpiFixed {
    static constexpr bool PERM = true, MIDK = false;
    bf16_t* O; int pad0, pad1;
    __device__ __forceinline__ void operator()(const f32x4 (&acc)[2][2][4][2], const Unit& u, int wr, int wc, int fr, int fq, int lane) const {
        bf16_t* dst = O + (size_t)blockIdx.x * 65536;
        unsigned o0 = ((unsigned)(wr * 64 + fr) * 256u + (unsigned)(wc * 32 + 8 * fq)) * 2u;
        asm volatile("" : "+v"(o0));
#pragma unroll
        for (int ai = 0; ai < 2; ++ai)
#pragma unroll
            for (int m = 0; m < 4; ++m) {
#pragma unroll
                for (int bj = 0; bj < 2; ++bj) { const f32x4 v0 = acc[ai][bj][m][0], v1 = acc[ai][bj][m][1];
                    u32x4 w; w.x = cvt_pk_bf16(v0[0], v0[1]); w.y = cvt_pk_bf16(v0[2], v0[3]); w.z = cvt_pk_bf16(v1[0], v1[1]); w.w = cvt_pk_bf16(v1[2], v1[3]);
                    *(u32x4*)((char*)dst + o0 + (unsigned)((ai * HALF + m * 16) * 256 + bj * HALF) * 2u) = w; } }
    }
};
struct EpiNone {
    static constexpr bool PERM = true, MIDK = false;
    int pad0, pad1;
    __device__ __forceinline__ void operator()(const f32x4 (&acc)[2][2][4][2], const Unit& u, int wr, int wc, int fr, int fq, int lane) const {
#pragma unroll
        for (int ai = 0; ai < 2; ++ai)
#pragma unroll
            for (int m = 0; m < 4; ++m) asm volatile("" :: "v"(acc[ai][0][m][0]), "v"(acc[ai][0][m][1]), "v"(acc[ai][1][m][0]), "v"(acc[ai][1][m][1]));
    }
};
struct EpiPart {
    static constexpr bool PERM = true, MIDK = false;
    bf16_t* P; size_t delta; int ldc, pad;
    __device__ __forceinline__ void operator()(const f32x4 (&acc)[2][2][4][2], const Unit& u, int wr, int wc, int fr, int fq, int lane) const {
        bf16_t* dst = P + (size_t)(u.k0 / u.nk) * delta;
        unsigned o0 = ((unsigned)(u.pm * BM + wr * 64 + fr) * (unsigned)ldc + (unsigned)(u.pn * BM + wc * 32 + 8 * fq)) * 2u;
#pragma unroll
        for (int ai = 0; ai < 2; ++ai)
#pragma unroll
            for (int m = 0; m < 4; ++m) {
#pragma unroll
                for (int bj = 0; bj < 2; ++bj) { const f32x4 v0 = acc[ai][bj][m][0], v1 = acc[ai][bj][m][1];
                    u32x4 w; w.x = cvt_pk_bf16(v0[0], v0[1]); w.y = cvt_pk_bf16(v0[2], v0[3]); w.z = cvt_pk_bf16(v1[0], v1[1]); w.w = cvt_pk_bf16(v1[2], v1[3]);
                    *(u32x4*)((char*)dst + o0 + (unsigned)((ai * HALF + m * 16) * ldc + bj * HALF) * 2u) = w; } }
    }
};

__device__ __forceinline__ void st16(void* base, unsigned boff, u32x4 v) { *(u32x4*)((char*)base + boff) = v; }
__device__ __forceinline__ u32x4 ld16(const void* base, unsigned boff) { return *(const u32x4*)((const char*)base + boff); }
struct EpiIn {
    static constexpr bool PERM = true, MIDK = false;
    bf16_t *U, *Q, *SA; float* out; float2* stats; const float2* rope; int layer, pad;
    __device__ __forceinline__ void operator()(const f32x4 (&acc)[2][2][4][2], const Unit& u, int wr, int wc, int fr, int fq, int lane) const {
        const int pn = u.pn, pm = u.pm;
        const unsigned rbase = (unsigned)(pm * BM + wr * 64 + fr);
        const unsigned cloc = (unsigned)(wc * 32 + 8 * fq);
        if (pn < 8) {
            bf16_t* dst = U + (size_t)(pn >> 2) * (size_t)(WS_VG - WS_U) / 2 + (pn & 3) * 256;
            const unsigned o0 = (rbase * AW + cloc) * 2u;
            const unsigned so0 = (rbase * 16u + (unsigned)((pn - 4) * 4 + wc)) * 8u;
#pragma unroll
            for (int ai = 0; ai < 2; ++ai)
#pragma unroll
                for (int m = 0; m < 4; ++m) { float s1 = 0.f, s2 = 0.f;
#pragma unroll
                    for (int bj = 0; bj < 2; ++bj) { float g[8];
#pragma unroll
                        for (int e = 0; e < 4; ++e) { g[e] = gelu_tanh(acc[ai][bj][m][0][e]); g[4 + e] = gelu_tanh(acc[ai][bj][m][1][e]); }
#pragma unroll
                        for (int e = 0; e < 8; ++e) { s1 += g[e]; s2 += g[e] * g[e]; }
                        u32x4 w; w.x = cvt_pk_bf16(g[0], g[1]); w.y = cvt_pk_bf16(g[2], g[3]); w.z = cvt_pk_bf16(g[4], g[5]); w.w = cvt_pk_bf16(g[6], g[7]);
                        st16(dst, o0 + (unsigned)((ai * HALF + m * 16) * AW + bj * HALF) * 2u, w); }
                    if (pn >= 4) { s1 += __shfl_xor(s1, 16); s1 += __shfl_xor(s1, 32); s2 += __shfl_xor(s2, 16); s2 += __shfl_xor(s2, 32);
                        if (fq == 0) *(float2*)((char*)stats + so0 + (unsigned)((ai * HALF + m * 16) * 16 * 8)) = make_float2(s1, s2); }
                    asm volatile("" ::: "memory"); }
        } else if (pn < 20) {
            const int which = (pn - 8) >> 2, ct = (pn - 8) & 3;
            bf16_t* dst = Q + (size_t)which * (size_t)(WS_K - WS_Q) / 2 + ct * 256;
            const unsigned o0 = (rbase * NAW + cloc) * 2u;
            const bool smp = pm >= 32;
            if (smp && which < 2) {
                const int axis = wc & 1; const bool second = fq >= 2; const int fi = 8 * (fq & 1);
                float4 tq[2][4];
#define ROPE_LD(t, ai_, m_) do { const int pos_ = axis ? (16 * (m_) + fr) : (4 * ((pm - 32) & 3) + 2 * (ai_) + wr); \
                    const float4* rp_ = (const float4*)((const char*)rope + (unsigned)(pos_ * 16 + fi) * 8u); t[0] = rp_[0]; t[1] = rp_[1]; t[2] = rp_[2]; t[3] = rp_[3]; } while (0)
#pragma unroll
                for (int ai = 0; ai < 2; ++ai)
#pragma unroll
                    for (int m = 0; m < 4; ++m) {
                        if (ai == 0 && m == 0) ROPE_LD(tq[0], 0, 0);
                        if (ai * 4 + m < 7) ROPE_LD(tq[(ai * 4 + m + 1) & 1], (ai * 4 + m + 1) >> 2, (ai * 4 + m + 1) & 3);
                        const float4 t0 = tq[(ai * 4 + m) & 1][0], t1 = tq[(ai * 4 + m) & 1][1], t2 = tq[(ai * 4 + m) & 1][2], t3 = tq[(ai * 4 + m) & 1][3];
                        const float cs[8] = {t0.x, t0.z, t1.x, t1.z, t2.x, t2.z, t3.x, t3.z}, sn[8] = {t0.y, t0.w, t1.y, t1.w, t2.y, t2.w, t3.y, t3.w};
#pragma unroll
                        for (int bj = 0; bj < 2; ++bj) { float v[8], o[8];
#pragma unroll
                            for (int e = 0; e < 4; ++e) { v[e] = acc[ai][bj][m][0][e]; v[4 + e] = acc[ai][bj][m][1][e]; }
#pragma unroll
                            for (int e = 0; e < 8; ++e) { const float p = __shfl_xor(v[e], 32); o[e] = second ? (v[e] * cs[e] + p * sn[e]) : (v[e] * cs[e] - p * sn[e]); }
                            u32x4 w; w.x = cvt_pk_bf16(o[0], o[1]); w.y = cvt_pk_bf16(o[2], o[3]); w.z = cvt_pk_bf16(o[4], o[5]); w.w = cvt_pk_bf16(o[6], o[7]);
                            st16(dst, o0 + (unsigned)((ai * HALF + m * 16) * NAW + bj * HALF) * 2u, w); }
                        asm volatile("" ::: "memory"); }
            } else {
#pragma unroll
                for (int ai = 0; ai < 2; ++ai)
#pragma unroll
                    for (int m = 0; m < 4; ++m) {
#pragma unroll
                        for (int bj = 0; bj < 2; ++bj) { const f32x4 v0 = acc[ai][bj][m][0], v1 = acc[ai][bj][m][1];
                            u32x4 w; w.x = cvt_pk_bf16(v0[0], v0[1]); w.y = cvt_pk_bf16(v0[2], v0[3]); w.z = cvt_pk_bf16(v1[0], v1[1]); w.w = cvt_pk_bf16(v1[2], v1[3]);
                            st16(dst, o0 + (unsigned)((ai * HALF + m * 16) * NAW + bj * HALF) * 2u, w); }
                        asm volatile("" ::: "memory"); }
            }
        } else {
            const int t = pn - 20;
            const unsigned o0 = (rbase * D + (unsigned)(t * 128) + cloc) * 2u;
#pragma unroll
            for (int ai = 0; ai < 2; ++ai)
#pragma unroll
                for (int m = 0; m < 4; ++m) { float ga[8], gb[8];
#pragma unroll
                    for (int e = 0; e < 4; ++e) { ga[e] = sigmoidf(acc[ai][0][m][0][e]); ga[4 + e] = sigmoidf(acc[ai][0][m][1][e]);
                        gb[e] = fmaxf(sigmoidf(acc[ai][1][m][0][e]), 1e-13f); gb[4 + e] = fmaxf(sigmoidf(acc[ai][1][m][1][e]), 1e-13f); }
#pragma unroll
                    for (int e = 0; e < 8; ++e) ga[e] *= __builtin_amdgcn_rcpf(gb[e]);
                    u32x4 w; w.x = cvt_pk_bf16(ga[0], ga[1]); w.y = cvt_pk_bf16(ga[2], ga[3]); w.z = cvt_pk_bf16(ga[4], ga[5]); w.w = cvt_pk_bf16(ga[6], ga[7]);
                    st16(SA, o0 + (unsigned)((ai * HALF + m * 16) * D) * 2u, w);
                    u32x4 v; v.x = cvt_pk_bf16(gb[0], gb[1]); v.y = cvt_pk_bf16(gb[2], gb[3]); v.z = cvt_pk_bf16(gb[4], gb[5]); v.w = cvt_pk_bf16(gb[6], gb[7]);
                    st16(SA + (size_t)(WS_SB - WS_SA) / 2, o0 + (unsigned)((ai * HALF + m * 16) * D) * 2u, v);
                    asm volatile("" ::: "memory"); }
        }
    }
};

struct EpiMerge {
    static constexpr bool PERM = true, MIDK = true;
    const bf16_t *SA, *SB; bf16_t* MG;
    __device__ __forceinline__ void mid(f32x4 (&acc)[2][2][4][2], const Unit& u, int wr, int wc, int fr, int fq) const {
        unsigned o0 = ((unsigned)(u.pm * BM + wr * 64 + fr) * D + (unsigned)(u.pn * BM + wc * 32 + 8 * fq)) * 2u;
        asm volatile("" : "+v"(o0));
#pragma unroll
        for (int ai = 0; ai < 2; ++ai) {
            u32x4 a[4][2];
#pragma unroll
            for (int m = 0; m < 4; ++m)
#pragma unroll
                for (int bj = 0; bj < 2; ++bj) a[m][bj] = ld16(SA, o0 + (unsigned)((ai * HALF + m * 16) * D + bj * HALF) * 2u);
#pragma unroll
            for (int m = 0; m < 4; ++m) {
#pragma unroll
                for (int bj = 0; bj < 2; ++bj) { const u32x4 t = a[m][bj];
                    const f32x4 r0 = {bflo(t.x), bfhi(t.x), bflo(t.y), bfhi(t.y)}, r1 = {bflo(t.z), bfhi(t.z), bflo(t.w), bfhi(t.w)};
                    acc[ai][bj][m][0] *= r0; acc[ai][bj][m][1] *= r1; }
                asm volatile("" : "+v"(acc[ai][0][m][0]), "+v"(acc[ai][0][m][1]), "+v"(acc[ai][1][m][0]), "+v"(acc[ai][1][m][1])); }
            asm volatile("" ::: "memory"); }
    }
    __device__ __forceinline__ void operator()(const f32x4 (&acc)[2][2][4][2], const Unit& u, int wr, int wc, int fr, int fq, int lane) const {
        unsigned o0 = ((unsigned)(u.pm * BM + wr * 64 + fr) * D + (unsigned)(u.pn * BM + wc * 32 + 8 * fq)) * 2u;
        asm volatile("" : "+v"(o0));
#pragma unroll
        for (int ai = 0; ai < 2; ++ai) {
            u32x4 sb[4][2];
#pragma unroll
            for (int m = 0; m < 4; ++m)
#pragma unroll
                for (int bj = 0; bj < 2; ++bj) sb[m][bj] = ld16(SB, o0 + (unsigned)((ai * HALF + m * 16) * D + bj * HALF) * 2u);
#pragma unroll
            for (int m = 0; m < 4; ++m)
#pragma unroll
                for (int bj = 0; bj < 2; ++bj) { const unsigned o = o0 + (unsigned)((ai * HALF + m * 16) * D + bj * HALF) * 2u;
                    const u32x4 b = sb[m][bj];
                    const f32x4 v0 = acc[ai][bj][m][0], v1 = acc[ai][bj][m][1];
                    u32x4 w; w.x = cvt_pk_bf16(v0[0] * bflo(b.x), v0[1] * bfhi(b.x)); w.y = cvt_pk_bf16(v0[2] * bflo(b.y), v0[3] * bfhi(b.y));
                    w.z = cvt_pk_bf16(v1[0] * bflo(b.z), v1[1] * bfhi(b.z)); w.w = cvt_pk_bf16(v1[2] * bflo(b.w), v1[3] * bfhi(b.w));
                    st16(MG, o, w); }
            asm volatile("" ::: "memory"); }
    }
};

template <class Epi, class Sched, bool ALIGN_EPI = true>
__device__ __forceinline__ void gemm_phase(LAS unsigned char* lds, const Gemm g, const Sched& S, const Epi& E) {
    int tid = threadIdx.x; asm volatile("" : "+v"(tid));
    const int wid = __builtin_amdgcn_readfirstlane(tid >> 6), lane = tid & 63, wr = wid >> 2, wc = wid & 3, fr = lane & 15, fq = lane >> 4;
    unsigned voffA[2], voffB[2];
#pragma unroll
    for (int i = 0; i < 2; ++i) { int R, C; stage_rc(tid * 16 + i * 8192, R, C); const int Rb = Epi::PERM ? ((R & ~31) + perm32(R & 31)) : R;
        voffA[i] = (unsigned)(R * g.lda + C) * 2u; voffB[i] = (unsigned)(Rb * g.ldb + C) * 2u; }
    const size_t kstep = (size_t)(BK * 2);
    const size_t hsA = (size_t)HALF * g.lda * 2, hsB = (size_t)HALF * g.ldb * 2;
    const size_t tsA = 2 * hsA, tsB = 2 * hsB;
    const unsigned ldsw = (unsigned)wid * 1024u;
    const int aoff = lds_byte(wr * 64 + fr, fq * 8), boff = lds_byte(wc * 32 + fr, fq * 8);
#define PG8_SA(b, h) (((b) * 2 + (h)) * HTB)
#define PG8_SB(b, h) ((4 + (b) * 2 + (h)) * HTB)
#define PG8_STAGE(bufoff, gbase, voff) do { _Pragma("unroll") for (int _i = 0; _i < 2; ++_i) \
        __builtin_amdgcn_global_load_lds((const unsigned*)((const char*)(gbase) + (voff)[_i]), (LAS unsigned*)(lds + (bufoff) + ldsw + _i * 8192), 16, 0, 0); } while (0)
#define PG8_LDA(dst, b, h) do { _Pragma("unroll") for (int m = 0; m < 4; ++m) _Pragma("unroll") for (int k = 0; k < 2; ++k) dst[m][k] = *(const LAS bf16x8*)(lds + PG8_SA(b, h) + aoff + m * 2048 + k * 1024); } while (0)
#define PG8_LDB(dst, b, h) do { _Pragma("unroll") for (int n = 0; n < 2; ++n) _Pragma("unroll") for (int k = 0; k < 2; ++k) dst[n][k] = *(const LAS bf16x8*)(lds + PG8_SB(b, h) + boff + n * 2048 + k * 1024); } while (0)
#define PG8_MMA(ai, bj, At, Bt) do { __builtin_amdgcn_s_setprio(1); _Pragma("unroll") for (int m = 0; m < 4; ++m) _Pragma("unroll") for (int n = 0; n < 2; ++n) _Pragma("unroll") for (int k = 0; k < 2; ++k) \
        acc[ai][bj][m][n] = __builtin_amdgcn_mfma_f32_16x16x32_bf16(Bt[n][k], At[m][k], acc[ai][bj][m][n], 0, 0, 0); __builtin_amdgcn_s_setprio(0); } while (0)
#define PG8_WAIT_V(n) asm volatile("s_waitcnt vmcnt(" #n ")" ::: "memory")
#define PG8_WAIT_L(n) asm volatile("s_waitcnt lgkmcnt(" #n ")" ::: "memory")
#define PG8_BAR __builtin_amdgcn_s_barrier()
#define PG8_SCHED __builtin_amdgcn_sched_barrier(0)
    Unit cur, nxt; int ui = 0;
    if (!S.next(0, cur)) return;
    f32x4 acc[2][2][4][2];
#pragma unroll
    for (int a = 0; a < 2; ++a)
#pragma unroll
        for (int b = 0; b < 2; ++b)
#pragma unroll
            for (int m = 0; m < 4; ++m)
#pragma unroll
                for (int n = 0; n < 2; ++n) acc[a][b][m][n] = (f32x4){0.f, 0.f, 0.f, 0.f};
    bf16x8 At[4][2], B0[2][2], B1[2][2];
    const char* cA = (const char*)g.A + (size_t)cur.pm * tsA + (size_t)cur.k0 * kstep; const char* cB = (const char*)g.Bt + (size_t)cur.pn * tsB + (size_t)cur.k0 * kstep;
    PG8_STAGE(PG8_SB(0, 0), cB, voffB); PG8_STAGE(PG8_SB(0, 1), cB + hsB, voffB); PG8_STAGE(PG8_SA(0, 0), cA, voffA); PG8_STAGE(PG8_SA(0, 1), cA + hsA, voffA);
    if (wr == 1) PG8_BAR;
    PG8_WAIT_V(2); PG8_BAR;
    PG8_STAGE(PG8_SB(1, 0), cB + kstep, voffB); PG8_STAGE(PG8_SA(1, 0), cA + kstep, voffA); PG8_STAGE(PG8_SB(1, 1), cB + hsB + kstep, voffB);
    PG8_WAIT_V(6); PG8_BAR;
    for (;;) {
        const bool has_next = S.next(ui + 1, nxt);
        const char* nA = has_next ? (const char*)g.A + (size_t)nxt.pm * tsA + (size_t)nxt.k0 * kstep : cA; const char* nB = has_next ? (const char*)g.Bt + (size_t)nxt.pn * tsB + (size_t)nxt.k0 * kstep : cB;
        const int nt = cur.nk;
        for (int t = 0; t < nt; t += 2) {
            const bool last = (t == nt - 2);
            if constexpr (Epi::MIDK) { if (t == (nt >> 1)) E.mid(acc, cur, wr, wc, fr, fq); }
            const char* a1 = cA + (size_t)(t + 1) * kstep;
            const char* a2 = last ? nA : cA + (size_t)(t + 2) * kstep; const char* b2 = last ? nB : cB + (size_t)(t + 2) * kstep;
            const char* a3 = a2 + kstep; const char* b3 = b2 + kstep;
            PG8_LDB(B0, 0, 0); PG8_LDB(B1, 0, 1); PG8_SCHED; PG8_LDA(At, 0, 0); PG8_STAGE(PG8_SA(1, 1), a1 + hsA, voffA);
            PG8_WAIT_V(8); PG8_WAIT_L(0); PG8_BAR; PG8_MMA(0, 0, At, B0); PG8_MMA(0, 1, At, B1); PG8_BAR; PG8_SCHED;
            PG8_LDA(At, 0, 1); PG8_STAGE(PG8_SB(0, 0), b2, voffB); PG8_STAGE(PG8_SB(0, 1), b2 + hsB, voffB); PG8_STAGE(PG8_SA(0, 0), a2, voffA);
            PG8_WAIT_V(8); PG8_WAIT_L(0); PG8_BAR; PG8_MMA(1, 0, At, B0); PG8_MMA(1, 1, At, B1); PG8_BAR; PG8_SCHED;
            PG8_LDB(B0, 1, 0); PG8_LDB(B1, 1, 1); PG8_SCHED; PG8_LDA(At, 1, 0); PG8_STAGE(PG8_SA(0, 1), a2 + hsA, voffA);
            PG8_WAIT_V(8); PG8_WAIT_L(0); PG8_BAR; PG8_MMA(0, 0, At, B0); PG8_MMA(0, 1, At, B1); PG8_BAR; PG8_SCHED;
            PG8_LDA(At, 1, 1); PG8_STAGE(PG8_SB(1, 0), b3, voffB); PG8_STAGE(PG8_SB(1, 1), b3 + hsB, voffB); PG8_STAGE(PG8_SA(1, 0), a3, voffA);
            PG8_WAIT_V(8); PG8_WAIT_L(0); PG8_BAR; PG8_MMA(1, 0, At, B0); PG8_MMA(1, 1, At, B1); PG8_BAR; PG8_SCHED;
        }
        if constexpr (ALIGN_EPI) { if (wr == 0) PG8_BAR; }
        E(acc, cur, wr, wc, fr, fq, lane);
        if (!has_next) break;
#pragma unroll
        for (int a = 0; a < 2; ++a)
#pragma unroll
            for (int b = 0; b < 2; ++b)
#pragma unroll
                for (int m = 0; m < 4; ++m)
#pragma unroll
                    for (int n = 0; n < 2; ++n) acc[a][b][m][n] = (f32x4){0.f, 0.f, 0.f, 0.f};
        cur = nxt; cA = nA; cB = nB; ++ui;
        if constexpr (ALIGN_EPI) { if (wr == 1) PG8_BAR; }
    }
    PG8_WAIT_V(0);
    if constexpr (!ALIGN_EPI) { if (wr == 0) PG8_BAR; }
    PG8_BAR;
#undef PG8_SA
#undef PG8_SB
#undef PG8_STAGE
#undef PG8_LDA
#undef PG8_LDB
#undef PG8_MMA
#undef PG8_WAIT_V
#undef PG8_WAIT_L
#undef PG8_BAR
#undef PG8_SCHED
}
}

namespace mix {
typedef float f32x16 __attribute__((ext_vector_type(16)));
typedef float f32x4 __attribute__((ext_vector_type(4)));
typedef short bf16x8 __attribute__((ext_vector_type(8)));
typedef short s16x4 __attribute__((ext_vector_type(4)));
typedef unsigned u32x4 __attribute__((ext_vector_type(4)));
typedef unsigned u32x2 __attribute__((ext_vector_type(2)));
constexpr int VS = 144;
constexpr int RPB_OFF = 9216;
constexpr int SG_STRIDE = 80, SG_MU = 10240, SG_RS = 10240 + 512;
constexpr float SCL = 0.125f * 1.4426950408889634f, LOG2E = 1.4426950408889634f;

__device__ __forceinline__ s16x4 tr4(LAS unsigned char* p) { return __builtin_bit_cast(s16x4, __builtin_amdgcn_ds_read_tr16_b64_v4i16((LAS s16x4*)p)); }
__device__ __forceinline__ bf16x8 cat8(s16x4 a, s16x4 b) { return (bf16x8){a[0], a[1], a[2], a[3], b[0], b[1], b[2], b[3]}; }
__device__ __forceinline__ unsigned cvtpk(float lo, float hi) { unsigned r; asm volatile("v_cvt_pk_bf16_f32 %0, %1, %2" : "=v"(r) : "v"(lo), "v"(hi)); return r; }

struct FState { f32x16 o0, o1; float m, l; };

template <bool PLAIN, class Fn>
__device__ __forceinline__ void fa_block(FState& st, const bf16x8 (&qf)[4], const bf16x8 (&kf)[4], LAS unsigned char* vt, int lane, Fn&& fn) {
    f32x16 s;
#pragma unroll
    for (int r = 0; r < 16; ++r) s[r] = 0.f;
#pragma unroll
    for (int d0 = 0; d0 < 4; ++d0) s = __builtin_amdgcn_mfma_f32_32x32x16_bf16(kf[d0], qf[d0], s, 0, 0, 0);
    if (!PLAIN) fn(s);
    float mx = fmaxf(fmaxf(s[0], s[1]), s[2]);
#pragma unroll
    for (int r = 3; r < 15; r += 2) mx = fmaxf(fmaxf(mx, s[r]), s[r + 1]);
    mx = fmaxf(mx, s[15]);
    mx = fmaxf(mx, __shfl_xor(mx, 32));
    if (PLAIN) mx *= SCL;
    if (__builtin_amdgcn_ballot_w64(mx - st.m > 8.f) != 0ull) {
        const float mn = fmaxf(st.m, mx), alpha = __builtin_amdgcn_exp2f(st.m - mn);
        st.l *= alpha; st.m = mn;
#pragma unroll
        for (int r = 0; r < 16; ++r) { st.o0[r] *= alpha; st.o1[r] *= alpha; }
    }
    const float nm = -st.m; float ps = 0.f;
#pragma unroll
    for (int r = 0; r < 16; ++r) { s[r] = __builtin_amdgcn_exp2f(PLAIN ? __builtin_fmaf(s[r], SCL, nm) : (s[r] + nm)); ps += s[r]; }
    st.l += ps;
    u32x4 p0, p1;
    p0.x = cvtpk(s[0], s[1]); p0.y = cvtpk(s[2], s[3]); p0.z = cvtpk(s[4], s[5]); p0.w = cvtpk(s[6], s[7]);
    p1.x = cvtpk(s[8], s[9]); p1.y = cvtpk(s[10], s[11]); p1.z = cvtpk(s[12], s[13]); p1.w = cvtpk(s[14], s[15]);
    const bf16x8 pb0 = __builtin_bit_cast(bf16x8, p0), pb1 = __builtin_bit_cast(bf16x8, p1);
    const int h = lane >> 5, blk = (lane >> 4) & 1, qq = (lane & 15) >> 2, p = lane & 3;
    LAS unsigned char* vb = vt + (4 * h + qq) * VS + (16 * blk + 4 * p) * 2;
    const bf16x8 a00 = cat8(tr4(vb), tr4(vb + 8 * VS)), a01 = cat8(tr4(vb + 64), tr4(vb + 8 * VS + 64));
    const bf16x8 a10 = cat8(tr4(vb + 16 * VS), tr4(vb + 24 * VS)), a11 = cat8(tr4(vb + 16 * VS + 64), tr4(vb + 24 * VS + 64));
    st.o0 = __builtin_amdgcn_mfma_f32_32x32x16_bf16(a00, pb0, st.o0, 0, 0, 0);
    st.o1 = __builtin_amdgcn_mfma_f32_32x32x16_bf16(a01, pb0, st.o1, 0, 0, 0);
    st.o0 = __builtin_amdgcn_mfma_f32_32x32x16_bf16(a10, pb1, st.o0, 0, 0, 0);
    st.o1 = __builtin_amdgcn_mfma_f32_32x32x16_bf16(a11, pb1, st.o1, 0, 0, 0);
}

template <bool PLAIN, class FnA, class FnB>
__device__ __forceinline__ void fa_block2(FState& st, const bf16x8 (&qf)[4], const bf16x8 (&kfA)[4], const bf16x8 (&kfB)[4], LAS unsigned char* vtA, LAS unsigned char* vtB, int lane, FnA&& fnA, FnB&& fnB) {
    f32x16 sA, sB;
#pragma unroll
    for (int r = 0; r < 16; ++r) { sA[r] = 0.f; sB[r] = 0.f; }
#pragma unroll
    for (int d0 = 0; d0 < 4; ++d0) { sA = __builtin_amdgcn_mfma_f32_32x32x16_bf16(kfA[d0], qf[d0], sA, 0, 0, 0); sB = __builtin_amdgcn_mfma_f32_32x32x16_bf16(kfB[d0], qf[d0], sB, 0, 0, 0); }
    if (!PLAIN) { fnA(sA); fnB(sB); }
    float mxa = fmaxf(fmaxf(sA[0], sA[1]), sA[2]), mxb = fmaxf(fmaxf(sB[0], sB[1]), sB[2]);
#pragma unroll
    for (int r = 3; r < 15; r += 2) { mxa = fmaxf(fmaxf(mxa, sA[r]), sA[r + 1]); mxb = fmaxf(fmaxf(mxb, sB[r]), sB[r + 1]); }
    float mx = fmaxf(fmaxf(mxa, sA[15]), fmaxf(mxb, sB[15]));
    mx = fmaxf(mx, __shfl_xor(mx, 32));
    if (PLAIN) mx *= SCL;
    if (__builtin_amdgcn_ballot_w64(mx - st.m > 8.f) != 0ull) {
        const float mn = fmaxf(st.m, mx), alpha = __builtin_amdgcn_exp2f(st.m - mn);
        st.l *= alpha; st.m = mn;
#pragma unroll
        for (int r = 0; r < 16; ++r) { st.o0[r] *= alpha; st.o1[r] *= alpha; }
    }
    const float nm = -st.m; float psa = 0.f, psb = 0.f;
#pragma unroll
    for (int r = 0; r < 16; ++r) { sA[r] = __builtin_amdgcn_exp2f(PLAIN ? __builtin_fmaf(sA[r], SCL, nm) : (sA[r] + nm)); psa += sA[r];
                                   sB[r] = __builtin_amdgcn_exp2f(PLAIN ? __builtin_fmaf(sB[r], SCL, nm) : (sB[r] + nm)); psb += sB[r]; }
    st.l += psa + psb;
    u32x4 p0, p1, p2, p3;
    p0.x = cvtpk(sA[0], sA[1]); p0.y = cvtpk(sA[2], sA[3]); p0.z = cvtpk(sA[4], sA[5]); p0.w = cvtpk(sA[6], sA[7]);
    p1.x = cvtpk(sA[8], sA[9]); p1.y = cvtpk(sA[10], sA[11]); p1.z = cvtpk(sA[12], sA[13]); p1.w = cvtpk(sA[14], sA[15]);
    p2.x = cvtpk(sB[0], sB[1]); p2.y = cvtpk(sB[2], sB[3]); p2.z = cvtpk(sB[4], sB[5]); p2.w = cvtpk(sB[6], sB[7]);
    p3.x = cvtpk(sB[8], sB[9]); p3.y = cvtpk(sB[10], sB[11]); p3.z = cvtpk(sB[12], sB[13]); p3.w = cvtpk(sB[14], sB[15]);
    const bf16x8 pa0 = __builtin_bit_cast(bf16x8, p0), pa1 = __builtin_bit_cast(bf16x8, p1), pb0 = __builtin_bit_cast(bf16x8, p2), pb1 = __builtin_bit_cast(bf16x8, p3);
    const int h = lane >> 5, blk = (lane >> 4) & 1, qq = (lane & 15) >> 2, p = lane & 3;
    const int voff = (4 * h + qq) * VS + (16 * blk + 4 * p) * 2;
    LAS unsigned char* va = vtA + voff; LAS unsigned char* vb = vtB + voff;
    const bf16x8 a00 = cat8(tr4(va), tr4(va + 8 * VS)), a01 = cat8(tr4(va + 64), tr4(va + 8 * VS + 64));
    const bf16x8 a10 = cat8(tr4(va + 16 * VS), tr4(va + 24 * VS)), a11 = cat8(tr4(va + 16 * VS + 64), tr4(va + 24 * VS + 64));
    const bf16x8 b00 = cat8(tr4(vb), tr4(vb + 8 * VS)), b01 = cat8(tr4(vb + 64), tr4(vb + 8 * VS + 64));
    const bf16x8 b10 = cat8(tr4(vb + 16 * VS), tr4(vb + 24 * VS)), b11 = cat8(tr4(vb + 16 * VS + 64), tr4(vb + 24 * VS + 64));
    st.o0 = __builtin_amdgcn_mfma_f32_32x32x16_bf16(a00, pa0, st.o0, 0, 0, 0);
    st.o1 = __builtin_amdgcn_mfma_f32_32x32x16_bf16(a01, pa0, st.o1, 0, 0, 0);
    st.o0 = __builtin_amdgcn_mfma_f32_32x32x16_bf16(a10, pa1, st.o0, 0, 0, 0);
    st.o1 = __builtin_amdgcn_mfma_f32_32x32x16_bf16(a11, pa1, st.o1, 0, 0, 0);
    st.o0 = __builtin_amdgcn_mfma_f32_32x32x16_bf16(b00, pb0, st.o0, 0, 0, 0);
    st.o1 = __builtin_amdgcn_mfma_f32_32x32x16_bf16(b01, pb0, st.o1, 0, 0, 0);
    st.o0 = __builtin_amdgcn_mfma_f32_32x32x16_bf16(b10, pb1, st.o0, 0, 0, 0);
    st.o1 = __builtin_amdgcn_mfma_f32_32x32x16_bf16(b11, pb1, st.o1, 0, 0, 0);
}

template <bool PLAIN, class Fn>
__device__ __forceinline__ void fa_sweep(FState& st, const bf16x8 (&qf)[4], const bf16_t* kb, size_t kblk, const bf16_t* vb, size_t vpitch, size_t vblk, int nblk, LAS unsigned char* vt, int lane, Fn&& fn) {
    bf16x8 kf[4]; u32x4 vr[4];
#pragma unroll
    for (int d0 = 0; d0 < 4; ++d0) kf[d0] = *(const bf16x8*)(kb + 16 * d0);
#pragma unroll
    for (int i = 0; i < 4; ++i) vr[i] = *(const u32x4*)(vb + (size_t)(8 * i) * vpitch);
    LAS unsigned char* vw = vt + (lane >> 3) * VS + (lane & 7) * 16;
    for (int j = 0; j < nblk; ++j) {
#pragma unroll
        for (int i = 0; i < 4; ++i) *(LAS u32x4*)(vw + 8 * i * VS) = vr[i];
        bf16x8 kc[4];
#pragma unroll
        for (int d0 = 0; d0 < 4; ++d0) kc[d0] = kf[d0];
        const int jn = (j + 1 < nblk) ? j + 1 : j;
        const bf16_t* kn = kb + (size_t)jn * kblk; const bf16_t* vn = vb + (size_t)jn * vblk;
#pragma unroll
        for (int d0 = 0; d0 < 4; ++d0) kf[d0] = *(const bf16x8*)(kn + 16 * d0);
#pragma unroll
        for (int i = 0; i < 4; ++i) vr[i] = *(const u32x4*)(vn + (size_t)(8 * i) * vpitch);
        fa_block<PLAIN>(st, qf, kc, vt, lane, [&](f32x16& s) { fn(s, j); });
    }
}

template <bool PLAIN, class Fn>
__device__ __forceinline__ void fa_sweep2(FState& st, const bf16x8 (&qf)[4], const bf16_t* kb, unsigned koff, size_t kblk, const bf16_t* vb, unsigned voff, size_t vpitch, size_t vblk, int nblk, LAS unsigned char* vt, int lane, Fn&& fn) {
    bf16x8 kfa[4], kfb[4]; u32x4 vra[4], vrb[4];
    asm volatile("" : "+v"(koff), "+v"(voff));
#define FA_LDK(dst, blk) do { const char* p_ = (const char*)(kb + (size_t)(blk) * kblk); _Pragma("unroll") for (int d0 = 0; d0 < 4; ++d0) dst[d0] = *(const bf16x8*)(p_ + 32 * d0 + koff); } while (0)
#define FA_LDV(dst, blk) do { const char* p_ = (const char*)(vb + (size_t)(blk) * vblk); _Pragma("unroll") for (int i = 0; i < 4; ++i) dst[i] = *(const u32x4*)(p_ + (size_t)(8 * i) * vpitch * 2 + voff); } while (0)
    { const int j1 = nblk > 1 ? 1 : 0; FA_LDK(kfa, 0); FA_LDK(kfb, j1); FA_LDV(vra, 0); FA_LDV(vrb, j1); }
    LAS unsigned char* vw = vt + (lane >> 3) * VS + (lane & 7) * 16;
    int j = 0;
    for (; j + 1 < nblk; j += 2) {
#pragma unroll
        for (int i = 0; i < 4; ++i) { *(LAS u32x4*)(vw + 8 * i * VS) = vra[i]; *(LAS u32x4*)(vw + 32 * VS + 8 * i * VS) = vrb[i]; }
        bf16x8 kca[4], kcb[4];
#pragma unroll
        for (int d0 = 0; d0 < 4; ++d0) { kca[d0] = kfa[d0]; kcb[d0] = kfb[d0]; }
        const int ja = (j + 2 < nblk) ? j + 2 : nblk - 1, jb = (j + 3 < nblk) ? j + 3 : nblk - 1;
        FA_LDK(kfa, ja); FA_LDK(kfb, jb); FA_LDV(vra, ja); FA_LDV(vrb, jb);
        fa_block2<PLAIN>(st, qf, kca, kcb, vt, vt + 32 * VS, lane, [&](f32x16& s) { fn(s, j); }, [&](f32x16& s) { fn(s, j + 1); });
    }
    if (j < nblk) {
#pragma unroll
        for (int i = 0; i < 4; ++i) *(LAS u32x4*)(vw + 8 * i * VS) = vra[i];
        fa_block<PLAIN>(st, qf, kfa, vt, lane, [&](f32x16& s) { fn(s, j); });
    }
#undef FA_LDK
#undef FA_LDV
}

__device__ __forceinline__ void fa_init(FState& st) {
#pragma unroll
    for (int r = 0; r < 16; ++r) { st.o0[r] = 0.f; st.o1[r] = 0.f; }
    st.m = -1e30f; st.l = 0.f;
}
__device__ __forceinline__ void fa_store(const FState& st, bf16_t* dst  , int lane) {
    const int hi = lane >> 5;
    const float l = st.l + __shfl_xor(st.l, 32), inv = 1.f / l;
#pragma unroll
    for (int rg = 0; rg < 4; ++rg) {
        u32x2 w0, w1;
        w0.x = cvtpk(st.o0[4 * rg] * inv, st.o0[4 * rg + 1] * inv); w0.y = cvtpk(st.o0[4 * rg + 2] * inv, st.o0[4 * rg + 3] * inv);
        w1.x = cvtpk(st.o1[4 * rg] * inv, st.o1[4 * rg + 1] * inv); w1.y = cvtpk(st.o1[4 * rg + 2] * inv, st.o1[4 * rg + 3] * inv);
        *(u32x2*)(dst + 8 * rg + 4 * hi) = w0; *(u32x2*)(dst + 32 + 8 * rg + 4 * hi) = w1;
    }
}

template <class RowFn>
__device__ __forceinline__ void fa_store_rows(const FState& st, LAS unsigned char* tb, int lane, RowFn&& rowp) {
    const int q = lane & 31, hi = lane >> 5;
    const float l = st.l + __shfl_xor(st.l, 32), inv = 1.f / l;
    LAS unsigned char* wp = tb + q * VS + 8 * hi;
#pragma unroll
    for (int rg = 0; rg < 4; ++rg) {
        u32x2 w0, w1;
        w0.x = cvtpk(st.o0[4 * rg] * inv, st.o0[4 * rg + 1] * inv); w0.y = cvtpk(st.o0[4 * rg + 2] * inv, st.o0[4 * rg + 3] * inv);
        w1.x = cvtpk(st.o1[4 * rg] * inv, st.o1[4 * rg + 1] * inv); w1.y = cvtpk(st.o1[4 * rg + 2] * inv, st.o1[4 * rg + 3] * inv);
        *(LAS u32x2*)(wp + 16 * rg) = w0; *(LAS u32x2*)(wp + 64 + 16 * rg) = w1;
    }
#pragma unroll
    for (int i = 0; i < 4; ++i) { const int row = (lane >> 3) + 8 * i;
        const u32x4 v = *(const LAS u32x4*)(tb + row * VS + (lane & 7) * 16);
        *(u32x4*)(rowp(row) + (lane & 7) * 8) = v; }
}

struct MixArgs { const bf16_t *Q, *Kb, *Vb, *CK, *CV, *U, *VG, *Wsb; const float2* stats; const float *rpb, *lng, *lnb, *sgb; bf16_t* YAB; float* out; int layer; };

constexpr int CTX_K = 0, CTX_V = 256 * VS;
__device__ __forceinline__ void ctx_issue(const MixArgs& A, int bh, int tid, u32x4 (&kr)[4], u32x4 (&vr)[4]) {
    const int b = bh >> 4, h = bh & 15; const size_t row0 = (size_t)b * CS;
#pragma unroll
    for (int i = 0; i < 4; ++i) { const int id = tid + 512 * i, row = id >> 3, ch = id & 7;
        kr[i] = *(const u32x4*)(A.Kb + (row0 + row) * NAW + h * HD + ch * 8); vr[i] = *(const u32x4*)(A.Vb + (row0 + row) * NAW + h * HD + ch * 8); }
}
__device__ __forceinline__ void ctx_wg_phase(const MixArgs& A, LAS unsigned char* lds, int vw, int tid, int wave, int lane, bool wst) {
    asm volatile("" : "+v"(lane), "+v"(tid));
    const int r32 = lane & 31, hi = lane >> 5;
    u32x4 kr[4], vr[4];
    ctx_issue(A, 2 * vw, tid, kr, vr);
    for (int u = 0; u < 2; ++u) {
        const int bh = 2 * vw + u, b = bh >> 4, h = bh & 15; const size_t row0 = (size_t)b * CS;
        bf16x8 qf[4];
        { const bf16_t* qp = A.Q + (row0 + 32 * wave + r32) * NAW + h * HD + 8 * hi;
#pragma unroll
          for (int d0 = 0; d0 < 4; ++d0) qf[d0] = *(const bf16x8*)(qp + 16 * d0); }
#pragma unroll
        for (int i = 0; i < 4; ++i) { const int id = tid + 512 * i, row = id >> 3, ch = id & 7;
            *(LAS u32x4*)(lds + CTX_K + row * VS + ch * 16) = kr[i]; *(LAS u32x4*)(lds + CTX_V + row * VS + ch * 16) = vr[i]; }
        if (wst) {
            float* sk = A.out + OUT_K + (((size_t)b * NL + A.layer) * NH + h) * (size_t)(CS * HD);
            float* sv = sk + (OUT_V - OUT_K);
#pragma unroll
            for (int i = 0; i < 4; ++i) { const int id = tid + 512 * i; const unsigned o = (unsigned)((id >> 3) * HD + (id & 7) * 8);
                const u32x4 k4 = kr[i], v4 = vr[i];
                *(f32x4*)(sk + o) = (f32x4){bflo(k4.x), bfhi(k4.x), bflo(k4.y), bfhi(k4.y)}; *(f32x4*)(sk + o + 4) = (f32x4){bflo(k4.z), bfhi(k4.z), bflo(k4.w), bfhi(k4.w)};
                *(f32x4*)(sv + o) = (f32x4){bflo(v4.x), bfhi(v4.x), bflo(v4.y), bfhi(v4.y)}; *(f32x4*)(sv + o + 4) = (f32x4){bflo(v4.z), bfhi(v4.z), bflo(v4.w), bfhi(v4.w)}; }
        }
        if (u == 0) ctx_issue(A, bh + 1, tid, kr, vr);
        __syncthreads();
        FState st; fa_init(st);
        LAS unsigned char* kp = lds + CTX_K + r32 * VS + 16 * hi;
        for (int j = 0; j < 4; ++j) {
            bf16x8 kfa[4], kfb[4];
#pragma unroll
            for (int d0 = 0; d0 < 4; ++d0) { kfa[d0] = *(const LAS bf16x8*)(kp + (64 * j) * VS + 32 * d0); kfb[d0] = *(const LAS bf16x8*)(kp + (64 * j + 32) * VS + 32 * d0); }
            fa_block2<true>(st, qf, kfa, kfb, lds + CTX_V + (64 * j) * VS, lds + CTX_V + (64 * j + 32) * VS, lane, [&](f32x16&) {}, [&](f32x16&) {});
        }
        { bf16_t* y0 = A.YAB + (row0 + 32 * wave) * 2048 + 1024 + h * HD;
          fa_store_rows(st, lds + 2 * 256 * VS + wave * (32 * VS), lane, [&](int q) { return y0 + (size_t)q * 2048; }); }
        __syncthreads();
    }
}

__device__ __forceinline__ void smp_unit(const MixArgs& A, int su, LAS unsigned char* wl, int lane) {
    asm volatile("" : "+v"(lane));
    const int cb = su & 3, rp = (su >> 2) & 7, h = (su >> 5) & 15, b = su >> 9, r32 = lane & 31, hi = lane >> 5;
    const int qr = 2 * rp + (r32 >> 4), qc = 16 * cb + (r32 & 15);
    const size_t srow0 = (size_t)NCTX + (size_t)b * SS;
    const size_t qrow = srow0 + qr * GW + qc;
    LAS float* rl = (LAS float*)(wl + RPB_OFF);
    float tv[8];
    { const float* rp_ = A.rpb + ((size_t)A.layer * NH + h) * (15 * 31);
#pragma unroll
      for (int k = 0; k < 8; ++k) { const int i = lane + 64 * k; tv[k] = rp_[i < 15 * 31 ? i : 15 * 31 - 1]; } }
    bf16x8 qf[4];
    { const bf16_t* qp = A.Q + qrow * NAW + h * HD + 8 * hi;
#pragma unroll
      for (int d0 = 0; d0 < 4; ++d0) qf[d0] = *(const bf16x8*)(qp + 16 * d0); }
    FState st; fa_init(st);
    const size_t cbase = (((size_t)b * NL + A.layer) * NH + h) * (size_t)PAST * HD;
    fa_sweep2<true>(st, qf, A.CK + cbase, (unsigned)(r32 * HD + 8 * hi) * 2u, (size_t)32 * HD, A.CV + cbase, (unsigned)((lane >> 3) * HD + (lane & 7) * 8) * 2u, (size_t)HD, (size_t)32 * HD, PAST / 32, wl, lane,
             [&](f32x16&, int) {});
#pragma unroll
    for (int k = 0; k < 8; ++k) { const int i = lane + 64 * k; if (i < 15 * 31) rl[i] = tv[k] * LOG2E; }
    int rs0 = 2 * rp - 4; rs0 = rs0 < 0 ? 0 : (rs0 > GROWS - 8 ? GROWS - 8 : rs0);
    int rs1 = 2 * rp - 3; rs1 = rs1 < 0 ? 0 : (rs1 > GROWS - 8 ? GROWS - 8 : rs1);
    const int rsq = (r32 >> 4) ? rs1 : rs0;
    int cs0 = qc - 8; cs0 = cs0 < 0 ? 0 : (cs0 > GW - 16 ? GW - 16 : cs0);
    int c0 = 16 * cb - 8; c0 = c0 < 0 ? 0 : (c0 > 32 ? 32 : c0);
    const size_t wrow0 = srow0 + (size_t)rs0 * GW + c0;
    fa_sweep2<false>(st, qf, A.Kb + wrow0 * NAW + h * HD, (unsigned)(r32 * NAW + 8 * hi) * 2u, (size_t)GW * NAW, A.Vb + wrow0 * NAW + h * HD, (unsigned)((lane >> 3) * NAW + (lane & 7) * 8) * 2u, (size_t)NAW, (size_t)GW * NAW, rs1 + 8 - rs0, wl, lane,
             [&](f32x16& s, int j) {
                 const int kr = rs0 + j; const bool rowok = (kr >= rsq) && (kr < rsq + 8);
                 int ri = kr - qr + 7; ri = ri < 0 ? 0 : (ri > 14 ? 14 : ri);
                 const int kc0 = c0 + 4 * hi;
#pragma unroll
                 for (int rr = 0; rr < 16; ++rr) { const int kc = kc0 + (rr & 3) + 8 * (rr >> 2);
                     const bool valid = rowok && (kc >= cs0) && (kc < cs0 + 16);
                     int ci = kc - qc + 15; ci = ci < 0 ? 0 : (ci > 30 ? 30 : ci);
                     const float bias = rl[ri * 31 + ci];
                     s[rr] = valid ? __builtin_fmaf(s[rr], SCL, bias) : -INFINITY; } });
    { bf16_t* y0 = A.YAB + (srow0 + (size_t)(2 * rp) * GW + 16 * cb) * 2048 + 1024 + h * HD;
      fa_store_rows(st, wl + 11264, lane, [&](int q) { return y0 + (size_t)((q >> 4) * GW + (q & 15)) * 2048; }); }
}

__device__ __forceinline__ void sgu_unit(const MixArgs& A, int su, int db, LAS unsigned char* wl, int lane) {
    asm volatile("" : "+v"(lane));
    const int chunk = su >> 3, g = su & 7, r32 = lane & 31, hi = lane >> 5;
    const size_t row0 = (size_t)chunk * 128;
    const bf16_t* wg = A.Wsb + ((size_t)(A.layer * 8 + g) * 128 + r32) * 128 + 8 * hi;
    bf16x8 w[4][8];
#pragma unroll
    for (int ib = 0; ib < 2; ++ib)
#pragma unroll
        for (int ks = 0; ks < 8; ++ks) w[ib][ks] = *(const bf16x8*)(wg + (size_t)(32 * ib) * 128 + 16 * ks);
    LAS float* mu = (LAS float*)(wl + SG_MU); LAS float* rsd = (LAS float*)(wl + SG_RS);
#pragma unroll
    for (int k = 0; k < 2; ++k) { const int rr = lane + 64 * k; const float4* sp = (const float4*)(A.stats + (row0 + rr) * 16);
        float s1 = 0.f, s2 = 0.f;
#pragma unroll
        for (int i = 0; i < 8; ++i) { const float4 t = sp[i]; s1 += t.x + t.z; s2 += t.y + t.w; }
        const float mean = s1 * (1.f / AW), var = fmaxf(s2 * (1.f / AW) - mean * mean, 0.f);
        mu[rr] = mean; rsd[rr] = rsqrtf(var + EPS); }
    const int h = hi, blk = (lane >> 4) & 1, qq = (lane & 15) >> 2, p = lane & 3;
    LAS unsigned char* tb = wl + (8 * h + qq) * SG_STRIDE + (16 * blk + 4 * p) * 2;
    const float* bsg = A.sgb + (size_t)(A.layer * 8 + g) * 128;
    const int colg = g * 128 + 32 * db;
    u32x2 uu[4][4]; float bias[4];
#pragma unroll
    for (int ib = 0; ib < 4; ++ib) { const int i = 32 * ib + r32; bias[ib] = bsg[i];
        const bf16_t* up = A.U + (row0 + i) * AW + colg + 4 * hi;
#pragma unroll
        for (int rg = 0; rg < 4; ++rg) uu[ib][rg] = *(const u32x2*)(up + 8 * rg); }
    { const int ch = lane & 3; float gam[8], bet[8];
      const float4 g0 = *(const float4*)(A.lng + (size_t)A.layer * AW + colg + 8 * ch), g1 = *(const float4*)(A.lng + (size_t)A.layer * AW + colg + 8 * ch + 4);
      const float4 b0 = *(const float4*)(A.lnb + (size_t)A.layer * AW + colg + 8 * ch), b1 = *(const float4*)(A.lnb + (size_t)A.layer * AW + colg + 8 * ch + 4);
      gam[0] = g0.x; gam[1] = g0.y; gam[2] = g0.z; gam[3] = g0.w; gam[4] = g1.x; gam[5] = g1.y; gam[6] = g1.z; gam[7] = g1.w;
      bet[0] = b0.x; bet[1] = b0.y; bet[2] = b0.z; bet[3] = b0.w; bet[4] = b1.x; bet[5] = b1.y; bet[6] = b1.z; bet[7] = b1.w;
      u32x4 xr[8];
#pragma unroll
      for (int i = 0; i < 8; ++i) xr[i] = *(const u32x4*)(A.VG + (row0 + (lane >> 2) + 16 * i) * AW + colg + 8 * ch);
#pragma unroll
      for (int i = 0; i < 8; ++i) { const int row = (lane >> 2) + 16 * i; const u32x4 x = xr[i];
          const float m_ = mu[row], r_ = rsd[row];
          float v[8] = {bflo(x.x), bfhi(x.x), bflo(x.y), bfhi(x.y), bflo(x.z), bfhi(x.z), bflo(x.w), bfhi(x.w)};
#pragma unroll
          for (int e = 0; e < 8; ++e) v[e] = (v[e] - m_) * r_ * gam[e] + bet[e];
          u32x4 w; w.x = cvtpk(v[0], v[1]); w.y = cvtpk(v[2], v[3]); w.z = cvtpk(v[4], v[5]); w.w = cvtpk(v[6], v[7]);
          *(LAS u32x4*)(wl + row * SG_STRIDE + ch * 16) = w; } }
    bf16x8 tf[8];
#pragma unroll
    for (int ks = 0; ks < 8; ++ks) tf[ks] = cat8(tr4(tb + (16 * ks) * SG_STRIDE), tr4(tb + (16 * ks + 4) * SG_STRIDE));
#pragma unroll
    for (int ib = 0; ib < 4; ++ib) {
        if (ib + 2 < 4) {
#pragma unroll
            for (int ks = 0; ks < 8; ++ks) w[ib + 2][ks] = *(const bf16x8*)(wg + (size_t)(32 * (ib + 2)) * 128 + 16 * ks); }
        const int i = 32 * ib + r32;
        bf16_t* yp = A.YAB + (row0 + i) * 2048 + colg + 4 * hi;
        f32x16 acc;
#pragma unroll
        for (int rr = 0; rr < 16; ++rr) acc[rr] = 0.f;
#pragma unroll
        for (int ks = 0; ks < 8; ++ks) acc = __builtin_amdgcn_mfma_f32_32x32x16_bf16(tf[ks], w[ib][ks], acc, 0, 0, 0);
#pragma unroll
        for (int rg = 0; rg < 4; ++rg) {
            u32x2 o; o.x = cvtpk(bflo(uu[ib][rg].x) * (acc[4 * rg] + bias[ib]), bfhi(uu[ib][rg].x) * (acc[4 * rg + 1] + bias[ib]));
            o.y = cvtpk(bflo(uu[ib][rg].y) * (acc[4 * rg + 2] + bias[ib]), bfhi(uu[ib][rg].y) * (acc[4 * rg + 3] + bias[ib]));
            *(u32x2*)(yp + 8 * rg) = o; }
    }
}

__device__ __forceinline__ void mix_phase(const MixArgs& A, LAS unsigned char* lds, LAS unsigned* qctr, int vcu, int G, int tid, int wave, int lane, int sel = 7) {
    asm volatile("" : "+v"(lane), "+v"(tid));
    LAS unsigned char* wl = lds + wave * WLDS;
    int it = 0;
    for (int vw = vcu; vw < 256; vw += G, ++it) {
        if (sel & 4) ctx_wg_phase(A, lds, vw, tid, wave, lane, G != 256);
        const int nsgu = ((vw & 1) ? 2 : 3) * 4, sbase = 5 * (vw >> 1) + ((vw & 1) ? 3 : 0), ntot = 4 + nsgu;
        for (;;) {
            unsigned idx = 0;
            if (lane == 0) idx = __hip_atomic_fetch_add(qctr + it, 1u, __ATOMIC_RELAXED, __HIP_MEMORY_SCOPE_WORKGROUP);
            idx = (unsigned)__builtin_amdgcn_readfirstlane((int)idx);
            if ((int)idx >= ntot) break;
            if (idx < 4u) { if (sel & 1) smp_unit(A, 4 * vw + (int)idx, wl, lane); }
            else { if (sel & 2) sgu_unit(A, sbase + (((int)idx - 4) >> 2), ((int)idx - 4) & 3, wl, lane); }
        }
        __syncthreads();
    }
}
}

#define XB_TMO      128
#define XB_XCNT(j)  (256  + 64 * (j))
#define XB_XSUB(j)  (1280 + 64 * (j))
#define XB_XGEN(j)  (2304 + 64 * (j))
#define XB_TOP      3328
#define XB_TOPGEN   3392
#define XCD_BAR_WORDS 3456
#define XB_SPIN_CAP (1u << 18)

__device__ __forceinline__ unsigned xb_ld(unsigned* p)              { return __hip_atomic_load(p, __ATOMIC_RELAXED, __HIP_MEMORY_SCOPE_AGENT); }
__device__ __forceinline__ unsigned xb_add(unsigned* p, unsigned v) { return __hip_atomic_fetch_add(p, v, __ATOMIC_RELAXED, __HIP_MEMORY_SCOPE_AGENT); }
__device__ __forceinline__ unsigned xb_xcc_id() { return (unsigned)__builtin_amdgcn_s_getreg((3 << 11) | 20) & 0xFu; }
#define XB_SPIN(cond, bar) do { unsigned _sp = 0; while (cond) { __builtin_amdgcn_s_sleep(1); \
    if ((++_sp & 255u) == 0u) { if (xb_ld(&(bar)[XB_TMO])) break; if (_sp > XB_SPIN_CAP) { atomicAdd(&(bar)[XB_TMO], 1u); break; } } } } while (0)

struct XcdBarrier { unsigned* bar; unsigned x; volatile LAS unsigned* st; };

__device__ __forceinline__ XcdBarrier xcd_barrier_post(unsigned* bar, volatile LAS unsigned* st) {
    XcdBarrier b; b.bar = bar; b.x = xb_xcc_id(); b.st = st;
    if (threadIdx.x == 0) (void)xb_add(&bar[XB_XCNT(b.x)], 1u);
    return b;
}
__device__ __forceinline__ void xcd_barrier_complete(unsigned* bar, unsigned x, unsigned& nloc, unsigned& nx) {
    const unsigned G = gridDim.x * gridDim.y * gridDim.z;
    unsigned sum, cnt, mine, sp = 0u;
    for (;;) {
        sum = 0u; cnt = 0u; mine = 0u;
#pragma unroll
        for (unsigned j = 0; j < 16; ++j) { const unsigned c = xb_ld(&bar[XB_XCNT(j)]); sum += c; cnt += (c > 0u) ? 1u : 0u; mine = (j == x) ? c : mine; }
        if (sum == G) break;
        __builtin_amdgcn_s_sleep(1);
        if ((++sp & 255u) == 0u) { if (xb_ld(&bar[XB_TMO])) break; if (sp > XB_SPIN_CAP) { atomicAdd(&bar[XB_TMO], 1u); break; } }
    }
    nloc = mine > 0u ? mine : 1u; nx = cnt > 0u ? cnt : 1u;
}
__device__ __forceinline__ void xcd_barrier(const XcdBarrier& b) {
    asm volatile("s_waitcnt vmcnt(0)" ::: "memory");
    __syncthreads();
    if (threadIdx.x == 0) {
        unsigned* bar = b.bar;
        __builtin_amdgcn_s_waitcnt(0);
        unsigned nloc = b.st[0], nx = b.st[1];
        if (nloc == 0u) { xcd_barrier_complete(bar, b.x, nloc, nx); b.st[0] = nloc; b.st[1] = nx; }
        const unsigned old = xb_add(&bar[XB_XSUB(b.x)], 1u);
        const unsigned gen = old / nloc;
        if (old + 1u == (gen + 1u) * nloc) {
            __builtin_amdgcn_fence(__ATOMIC_RELEASE, "agent");
            asm volatile("s_waitcnt vmcnt(0)" ::: "memory");
            const unsigned og = xb_add(&bar[XB_TOP], 1u);
            const unsigned tg = og / nx;
            if (og + 1u == (tg + 1u) * nx) xb_add(&bar[XB_TOPGEN], 1u);
            else XB_SPIN(xb_ld(&bar[XB_TOPGEN]) == tg, bar);
            __builtin_amdgcn_fence(__ATOMIC_ACQUIRE, "agent");
            xb_add(&bar[XB_XGEN(b.x)], 1u);
            asm volatile("s_waitcnt vmcnt(0)" ::: "memory");
        } else {
            XB_SPIN(xb_ld(&bar[XB_XGEN(b.x)]) == gen, bar);
            __builtin_amdgcn_fence(__ATOMIC_ACQUIRE, "agent");
            asm volatile("s_waitcnt vmcnt(0)" ::: "memory");
        }
    }
    __syncthreads();
}

constexpr int I_IN = (D / 64) * (NIN / 32), I_PA = (AW / 64) * (D / 32), I_OUT = (D / 64) * (D / 32), I_F1 = (D / 64) * (DFF / 32), I_F2 = (DFF / 64) * (D / 32);
constexpr int I_LAYER = I_IN + 2 * I_PA + I_OUT + I_F1 + I_F2;
constexpr int I_SPLITA = 10112;
typedef unsigned mix_u32x4 __attribute__((ext_vector_type(4)));
struct ConvDesc { const float* src; bf16_t* dst; int N, ldo; };
__device__ __forceinline__ ConvDesc conv_desc(const Params& P, int l, int r) {
    unsigned char* ws = P.ws; const float* W; bf16_t* WT; int N, ldo, koff = 0, nbw;
    if (r < I_IN) { W = P.w_in + (size_t)l * D * NIN; N = NIN; WT = (bf16_t*)(ws + WS_WIN) + (size_t)l * NIN * D; ldo = D; nbw = NIN / 32; }
    else if ((r -= I_IN) < I_PA) { W = P.w_pa + (size_t)l * AW * D; N = D; WT = (bf16_t*)(ws + WS_WPAB) + (size_t)l * D * 2048; ldo = 2048; nbw = D / 32; }
    else if ((r -= I_PA) < I_PA) { W = P.w_pb + (size_t)l * NAW * D; N = D; WT = (bf16_t*)(ws + WS_WPAB) + (size_t)l * D * 2048; ldo = 2048; koff = 1024; nbw = D / 32; }
    else if ((r -= I_PA) < I_OUT) { W = P.w_out + (size_t)l * D * D; N = D; WT = (bf16_t*)(ws + WS_WOUT) + (size_t)l * D * D; ldo = D; nbw = D / 32; }
    else if ((r -= I_OUT) < I_F1) { W = P.w_ff1 + (size_t)l * D * DFF; N = DFF; WT = (bf16_t*)(ws + WS_WFF1) + (size_t)l * DFF * D; ldo = D; nbw = DFF / 32; }
    else { r -= I_F1; W = P.w_ff2 + (size_t)l * DFF * D; N = D; WT = (bf16_t*)(ws + WS_WFF2) + (size_t)l * D * DFF; ldo = DFF; nbw = D / 32; }
    const int kb = r / nbw, nb = r - kb * nbw;
    int nd = 32 * nb;
    if (N == NIN && nd >= 5120) { const int gB = nd >= 7168, g = nd - (gB ? 7168 : 5120); nd = 5120 + 256 * (g >> 7) + 128 * gB + (g & 127); }
    ConvDesc d; d.src = W + (size_t)(64 * kb) * N + 32 * nb; d.dst = WT + (size_t)nd * ldo + koff + 64 * kb; d.N = N; d.ldo = ldo; return d;
}
__device__ __forceinline__ void conv_load(const ConvDesc& d, mix::f32x4 (&wv)[8], int lane) {
    const float* p = d.src + (size_t)(lane >> 3) * d.N + 4 * (lane & 7);
#pragma unroll
    for (int i = 0; i < 8; ++i) wv[i] = __builtin_nontemporal_load((const mix::f32x4*)(p + (size_t)(8 * i) * d.N));
}
__device__ __forceinline__ void conv_store(const ConvDesc& d, const mix::f32x4 (&wv)[8], LAS float* scr, int lane) {
#pragma unroll
    for (int i = 0; i < 8; ++i) { LAS float* q = scr + (8 * i + (lane >> 3)) * 33 + 4 * (lane & 7); const mix::f32x4 t = wv[i]; q[0] = t[0]; q[1] = t[1]; q[2] = t[2]; q[3] = t[3]; }
    asm volatile("s_waitcnt lgkmcnt(0)" ::: "memory");
    const int c = lane & 7;
#pragma unroll
    for (int j = 0; j < 4; ++j) { const int n = (lane >> 3) + 8 * j; const LAS float* sp = scr + (8 * c) * 33 + n;
        uint4 o; o.x = pk2(sp[0 * 33], sp[1 * 33]); o.y = pk2(sp[2 * 33], sp[3 * 33]); o.z = pk2(sp[4 * 33], sp[5 * 33]); o.w = pk2(sp[6 * 33], sp[7 * 33]);
        __builtin_nontemporal_store((mix_u32x4){o.x, o.y, o.z, o.w}, (mix_u32x4*)(d.dst + (size_t)n * d.ldo + 8 * c)); }
    asm volatile("s_waitcnt lgkmcnt(0)" ::: "memory");
}
__device__ __forceinline__ void conv_stream(const Params& P, int l, int first, int end, int step, LAS float* scr, int lane) {
    asm volatile("" : "+v"(lane));
    if (first >= end) return;
    mix::f32x4 w0[8], w1[8], w2[8], w3[8];
    ConvDesc d0 = conv_desc(P, l, first), d1 = d0, d2 = d0, d3 = d0;
    conv_load(d0, w0, lane);
    if (first + step < end) { d1 = conv_desc(P, l, first + step); conv_load(d1, w1, lane); }
    if (first + 2 * step < end) { d2 = conv_desc(P, l, first + 2 * step); conv_load(d2, w2, lane); }
    for (int r = first; ; r += 4 * step) {
        if (r + 3 * step < end) { d3 = conv_desc(P, l, r + 3 * step); conv_load(d3, w3, lane); }
        conv_store(d0, w0, scr, lane);
        if (r + step >= end) break;
        if (r + 4 * step < end) { d0 = conv_desc(P, l, r + 4 * step); conv_load(d0, w0, lane); }
        conv_store(d1, w1, scr, lane);
        if (r + 2 * step >= end) break;
        if (r + 5 * step < end) { d1 = conv_desc(P, l, r + 5 * step); conv_load(d1, w1, lane); }
        conv_store(d2, w2, scr, lane);
        if (r + 3 * step >= end) break;
        if (r + 6 * step < end) { d2 = conv_desc(P, l, r + 6 * step); conv_load(d2, w2, lane); }
        conv_store(d3, w3, scr, lane);
        if (r + 4 * step >= end) break;
    }
}
__device__ __forceinline__ void conv_stream2(const Params& P, int l, int first, int end, int step, LAS float* scr, int lane) {
    asm volatile("" : "+v"(lane));
    if (first >= end) return;
    mix::f32x4 w0[8], w1[8];
    ConvDesc d0 = conv_desc(P, l, first), d1 = d0;
    conv_load(d0, w0, lane);
    for (int r = first; ; r += 2 * step) {
        if (r + step < end) { d1 = conv_desc(P, l, r + step); conv_load(d1, w1, lane); }
        conv_store(d0, w0, scr, lane);
        if (r + step >= end) break;
        if (r + 2 * step < end) { d0 = conv_desc(P, l, r + 2 * step); conv_load(d0, w0, lane); }
        conv_store(d1, w1, scr, lane);
        if (r + 2 * step >= end) break;
    }
}
__device__ __forceinline__ void cvt_flat(const float* src, bf16_t* dst, size_t n, size_t gtid, size_t gthreads) {
    for (size_t i = gtid * 8; i < n; i += gthreads * 32) {
        float4 a[4], b[4];
#pragma unroll
        for (int u = 0; u < 4; ++u) { const size_t j = i + (size_t)u * gthreads * 8; if (j < n) { a[u] = *(const float4*)(src + j); b[u] = *(const float4*)(src + j + 4); } }
#pragma unroll
        for (int u = 0; u < 4; ++u) { const size_t j = i + (size_t)u * gthreads * 8;
            if (j < n) { uint4 o; o.x = pk2(a[u].x, a[u].y); o.y = pk2(a[u].z, a[u].w); o.z = pk2(b[u].x, b[u].y); o.w = pk2(b[u].z, b[u].w); *(uint4*)(dst + j) = o; } } }
}

constexpr int N_STATE_ITEMS = CB * NH * 2 * 4;
__device__ __forceinline__ void state_load(const unsigned char* ws, int it, int lane, mix::u32x2 (&x)[16]) {
    const int piece = it & 3, kv = (it >> 2) & 1, bh = it >> 3, b = bh >> 4, h = bh & 15;
    const bf16_t* src = (const bf16_t*)(ws + (kv ? WS_V : WS_K)) + ((size_t)b * CS + 64 * piece) * NAW + h * HD;
    const unsigned lo = (unsigned)((lane >> 4) * NAW + (lane & 15) * 4) * 2u;
#pragma unroll
    for (int i = 0; i < 16; ++i) x[i] = __builtin_nontemporal_load((const mix::u32x2*)((const char*)src + (size_t)(4 * i) * NAW * 2 + lo));
}
__device__ __forceinline__ void state_store(float* out, int layer, int it, int lane, const mix::u32x2 (&x)[16]) {
    const int piece = it & 3, kv = (it >> 2) & 1, bh = it >> 3, b = bh >> 4, h = bh & 15;
    float* dst = out + (kv ? OUT_V : OUT_K) + (((size_t)b * NL + layer) * NH + h) * (size_t)(CS * HD) + (size_t)(64 * piece) * HD;
    const unsigned lo = (unsigned)((lane >> 4) * HD + (lane & 15) * 4) * 4u;
#pragma unroll
    for (int i = 0; i < 16; ++i) { const mix::u32x2 t = x[i];
        __builtin_nontemporal_store((mix::f32x4){bflo(t.x), bfhi(t.x), bflo(t.y), bfhi(t.y)}, (mix::f32x4*)((char*)dst + (size_t)(4 * i) * HD * 4 + lo)); }
}
__device__ __forceinline__ void state_stream(const Params& P, int layer, int first, int step, int lane) {
    asm volatile("" : "+v"(lane));
    if (first >= N_STATE_ITEMS) return;
    mix::u32x2 xa[16], xb[16];
    state_load(P.ws, first, lane, xa);
    for (int r = first; r < N_STATE_ITEMS; r += 2 * step) {
        const bool hb = r + step < N_STATE_ITEMS;
        if (hb) state_load(P.ws, r + step, lane, xb);
        state_store(P.out, layer, r, lane, xa);
        if (!hb) break;
        const bool ha = r + 2 * step < N_STATE_ITEMS;
        if (ha) state_load(P.ws, r + 2 * step, lane, xa);
        state_store(P.out, layer, r + step, lane, xb);
        if (!ha) break;
    }
}

__device__ __forceinline__ void prologue_phase(const Params& P, LAS unsigned char* lds, int vcu, int G, int tid, int wave, int lane) {
    asm volatile("" : "+v"(lane), "+v"(tid));
    unsigned char* ws = P.ws;
    {
        LAS float* sv = (LAS float*)lds;
        LAS float* red = (LAS float*)(lds + 3 * D * 4);
#pragma unroll
        for (int q = 0; q < D / NTHREADS; ++q) { const int k = tid + q * NTHREADS; const float a = P.c_ctx[k], b = P.c[k], d = P.c[D + k];
            sv[k] = a / (1.f + __expf(-a)); sv[D + k] = b / (1.f + __expf(-b)); sv[2 * D + k] = d / (1.f + __expf(-d)); }
        __syncthreads();
        float* mod = (float*)(ws + WS_MOD);
        const int cg = lane & 15, ksub = lane >> 4;
        constexpr int NU = NL * (6 * D / 64);
        const int nq = vcu < NU ? 8 * ((NU - 1 - vcu) / G + 1) : 0;
        unsigned loff = (unsigned)(ksub * (6 * D) + 4 * cg) * 4u; asm volatile("" : "+v"(loff));
        auto cbase = [&](int q) -> const char* { const int unit = vcu + G * (q >> 3), c = q & 7; const int l_ = unit / (6 * D / 64), n0_ = (unit % (6 * D / 64)) * 64;
            return (const char*)(P.w_mod + (size_t)l_ * D * (6 * D) + (size_t)(256 * wave + 32 * c) * (6 * D) + n0_); };
        mix::f32x4 x[8], a0 = {0.f, 0.f, 0.f, 0.f}, a1 = a0, a2 = a0;
        if (nq > 0) { const char* b0 = cbase(0);
#pragma unroll
            for (int j = 0; j < 8; ++j) x[j] = __builtin_nontemporal_load((const mix::f32x4*)(b0 + (size_t)(4 * j) * (6 * D) * 4 + loff)); }
        for (int q = 0; q < nq; ++q) {
            const int unit = vcu + G * (q >> 3), c = q & 7;
            const int l = unit / (6 * D / 64), n0 = (unit % (6 * D / 64)) * 64;
            const char* nb = cbase(q + 1 < nq ? q + 1 : q);
            const LAS float* svk = sv + 256 * wave + 32 * c + ksub;
#pragma unroll
            for (int j = 0; j < 8; ++j) { const mix::f32x4 xv = x[j];
                x[j] = __builtin_nontemporal_load((const mix::f32x4*)(nb + (size_t)(4 * j) * (6 * D) * 4 + loff));
                const float s0 = svk[4 * j], s1 = svk[D + 4 * j], s2 = svk[2 * D + 4 * j];
                a0 += s0 * xv; a1 += s1 * xv; a2 += s2 * xv; }
            if (c != 7) continue;
            float acc[3][4];
#pragma unroll
            for (int e = 0; e < 4; ++e) { acc[0][e] = a0[e]; acc[1][e] = a1[e]; acc[2][e] = a2[e]; }
            a0 = (mix::f32x4){0.f, 0.f, 0.f, 0.f}; a1 = a0; a2 = a0;
#pragma unroll
            for (int v = 0; v < 3; ++v)
#pragma unroll
                for (int e = 0; e < 4; ++e) { float a = acc[v][e]; a += __shfl_xor(a, 16); a += __shfl_xor(a, 32); acc[v][e] = a; }
            if (lane < 16) {
#pragma unroll
                for (int v = 0; v < 3; ++v)
#pragma unroll
                    for (int e = 0; e < 4; ++e) red[(wave * 3 + v) * 64 + 4 * cg + e] = acc[v][e]; }
            __syncthreads();
            if (tid < 192) { const int v = tid >> 6, n = tid & 63; float s = P.b_mod[(size_t)l * 6 * D + n0 + n];
#pragma unroll
                for (int w = 0; w < 8; ++w) s += red[(w * 3 + v) * 64 + n];
                mod[((size_t)l * 3 + v) * 6 * D + n0 + n] = s; }
            __syncthreads();
        }
    }
    {
        LAS float* scr = (LAS float*)(lds + wave * WLDS);
        const int gw = vcu * NWAVES + wave, NGW = G * NWAVES;
        if (G == 256) conv_stream(P, 0, gw, I_IN, NGW, scr, lane);
        else for (int l = 0; l < NL; ++l) conv_stream(P, l, gw, I_LAYER, NGW, scr, lane);
    }
    {
        const size_t gtid = (size_t)vcu * NTHREADS + tid, gth = (size_t)G * NTHREADS;
        cvt_flat(P.sgu_w, (bf16_t*)(ws + WS_WS), (size_t)NL * 8 * 128 * 128, gtid, gth);
        if (G != 256) {
        cvt_flat(P.cache_k, (bf16_t*)(ws + WS_CK), (size_t)SBT * NL * NH * PAST * HD, gtid, gth);
        cvt_flat(P.cache_v, (bf16_t*)(ws + WS_CV), (size_t)SBT * NL * NH * PAST * HD, gtid, gth); }
        if (gtid < 64 * 16) { const int pos = (int)gtid >> 4, f = (int)gtid & 15; const float freq = powf(10000.f, -(float)f / 16.f), ang = (float)pos * freq;
            ((float2*)(ws + WS_ROPE))[gtid] = make_float2(cosf(ang), sinf(ang)); }
    }
}

__device__ __forceinline__ void block_rowsum8(float (&v)[8], LAS float* buf, int wave, int lane, float (&tot)[8]) {
#pragma unroll
    for (int i = 0; i < 4; ++i) { const float keep = (lane & 4) ? v[i + 4] : v[i], send = (lane & 4) ? v[i] : v[i + 4]; v[i] = keep + __shfl_xor(send, 4); }
#pragma unroll
    for (int i = 0; i < 2; ++i) { const float keep = (lane & 2) ? v[i + 2] : v[i], send = (lane & 2) ? v[i] : v[i + 2]; v[i] = keep + __shfl_xor(send, 2); }
    { const float keep = (lane & 1) ? v[1] : v[0], send = (lane & 1) ? v[0] : v[1]; v[0] = keep + __shfl_xor(send, 1); }
    float t = v[0];
    t += __shfl_xor(t, 8); t += __shfl_xor(t, 16); t += __shfl_xor(t, 32);
    if (lane < 8) buf[wave * 8 + lane] = t;
    __syncthreads();
    float u = buf[lane];
    u += __shfl_xor(u, 8); u += __shfl_xor(u, 16); u += __shfl_xor(u, 32);
#pragma unroll
    for (int r = 0; r < 8; ++r) tot[r] = __builtin_bit_cast(float, __builtin_amdgcn_readlane(__builtin_bit_cast(int, u), r));
}
__device__ __forceinline__ void norm_phase(const Params& P, LAS unsigned char* lds, bool first, bool last, const bf16_t* y0, size_t ydelta, bool tail4, const float* modl, int gate_idx, const float* gpost,
                                           const float* modn, int pre_idx, const float* gpre, bf16_t* hout, int vcu, int G, int wave, int lane) {
    asm volatile("" : "+v"(lane));
    LAS float* red = (LAS float*)lds;
    const int col = 256 * wave + 4 * lane;
    const bool hasy = y0 != nullptr;
    int it = 0;
    bf16_t* XB = (bf16_t*)(P.ws + WS_XB);
    float4 xf[8]; uint2 xr[8], yr[8];
    auto issue = [&](int bb, float4 (&xf_)[8], uint2 (&xr_)[8], uint2 (&yr_)[8]) {
        const int r0 = 8 * bb;
        if (first) { const float* xb = r0 < NCTX ? P.x_prompt + (size_t)r0 * D : P.x_sample + (size_t)(r0 - NCTX) * D;
#pragma unroll
            for (int r = 0; r < 8; ++r) xf_[r] = *(const float4*)(xb + (size_t)r * D + col);
        } else {
#pragma unroll
            for (int r = 0; r < 8; ++r) xr_[r] = *(const uint2*)(XB + (size_t)(r0 + r) * D + col); }
        if (hasy) {
#pragma unroll
            for (int r = 0; r < 8; ++r) yr_[r] = *(const uint2*)(y0 + (size_t)(r0 + r) * D + col); }
    };
    if (vcu < M / 8) issue(vcu, xf, xr, yr);
    int cvc = -1; float4 GPv = make_float4(0.f, 0.f, 0.f, 0.f), Av = GPv, Bv = GPv;
    for (int b = vcu; b < M / 8; b += G, ++it) {
        const int row0 = 8 * b; const int cv = row0 < NCTX ? 0 : 1 + (row0 - NCTX) / SS;
        const int nparts = (tail4 && row0 >= NCTX) ? 4 : 1;
        if (cv != cvc) {
            cvc = cv;
            if (hasy) { const float4 g = *(const float4*)(modl + (size_t)cv * 6 * D + (size_t)gate_idx * D + col), p = *(const float4*)(gpost + col);
                GPv = make_float4(g.x * p.x, g.y * p.y, g.z * p.z, g.w * p.w); }
            if (hout) { const float* sh = modn + (size_t)cv * 6 * D + (size_t)pre_idx * D + col;
                const float4 gp = *(const float4*)(gpre + col), a = *(const float4*)sh, sc = *(const float4*)(sh + D);
                Av = make_float4(gp.x * (1.f + sc.x), gp.y * (1.f + sc.y), gp.z * (1.f + sc.z), gp.w * (1.f + sc.w)); Bv = a; }
        }
        const bool more = b + G < M / 8;
        float4 nxf[8]; uint2 nxr[8], nyr[8];
        if (more) issue(b + G, nxf, nxr, nyr);
        float4 xv[8]; float yv[8][4];
        if (first) {
#pragma unroll
            for (int r = 0; r < 8; ++r) xv[r] = xf[r];
        } else {
#pragma unroll
            for (int r = 0; r < 8; ++r) xv[r] = make_float4(bflo(xr[r].x), bfhi(xr[r].x), bflo(xr[r].y), bfhi(xr[r].y)); }
        if (hasy) {
#pragma unroll
            for (int r = 0; r < 8; ++r) { const uint2 t = yr[r];
                yv[r][0] = bflo(t.x); yv[r][1] = bfhi(t.x); yv[r][2] = bflo(t.y); yv[r][3] = bfhi(t.y); }
            if (nparts > 1) {
#pragma unroll
                for (int q = 1; q < 4; ++q)
#pragma unroll
                    for (int r = 0; r < 8; ++r) { const uint2 t = *(const uint2*)(y0 + (size_t)q * ydelta + (size_t)(row0 + r) * D + col);
                        yv[r][0] += bflo(t.x); yv[r][1] += bfhi(t.x); yv[r][2] += bflo(t.y); yv[r][3] += bfhi(t.y); } }
        }
        if (hasy) {
            float ps[8], tot[8];
#pragma unroll
            for (int r = 0; r < 8; ++r) ps[r] = yv[r][0] * yv[r][0] + yv[r][1] * yv[r][1] + yv[r][2] * yv[r][2] + yv[r][3] * yv[r][3];
            block_rowsum8(ps, red + ((it & 1) * 2 + 0) * 64, wave, lane, tot);
#pragma unroll
            for (int r = 0; r < 8; ++r) { const float rr = rsqrtf(tot[r] * (1.f / D) + EPS);
                xv[r].x += GPv.x * (yv[r][0] * rr); xv[r].y += GPv.y * (yv[r][1] * rr); xv[r].z += GPv.z * (yv[r][2] * rr); xv[r].w += GPv.w * (yv[r][3] * rr); }
        }
        if (last) { float* xo = P.out + OUT_X + (size_t)row0 * D + col;
#pragma unroll
            for (int r = 0; r < 8; ++r) *(float4*)(xo + (size_t)r * D) = xv[r];
        } else {
#pragma unroll
            for (int r = 0; r < 8; ++r) { uint2 o; o.x = pk2(xv[r].x, xv[r].y); o.y = pk2(xv[r].z, xv[r].w); *(uint2*)(XB + (size_t)(row0 + r) * D + col) = o; } }
        if (hout) {
            float ps[8], tot[8];
#pragma unroll
            for (int r = 0; r < 8; ++r) ps[r] = xv[r].x * xv[r].x + xv[r].y * xv[r].y + xv[r].z * xv[r].z + xv[r].w * xv[r].w;
            block_rowsum8(ps, red + ((it & 1) * 2 + 1) * 64, wave, lane, tot);
#pragma unroll
            for (int r = 0; r < 8; ++r) { const float rr = rsqrtf(tot[r] * (1.f / D) + EPS);
                uint2 o; o.x = pk2(xv[r].x * rr * Av.x + Bv.x, xv[r].y * rr * Av.y + Bv.y); o.y = pk2(xv[r].z * rr * Av.z + Bv.z, xv[r].w * rr * Av.w + Bv.w);
                *(uint2*)(hout + (size_t)(row0 + r) * D + col) = o; }
        }
        if (more) {
#pragma unroll
            for (int r = 0; r < 8; ++r) { if (first) xf[r] = nxf[r]; else xr[r] = nxr[r]; if (hasy) yr[r] = nyr[r]; } }
    }
    __syncthreads();
}

__global__ void __launch_bounds__(NTHREADS, 2) mk_fwd(Params P) {
    extern __shared__ __attribute__((aligned(16))) unsigned char lds_raw[];
    LAS unsigned char* lds = (LAS unsigned char*)lds_raw;
    volatile LAS unsigned* MISC = (volatile LAS unsigned*)(lds + MISC_OFF);
    const int tid = threadIdx.x, lane = tid & 63, wave = __builtin_amdgcn_readfirstlane(tid >> 6);
    const int G = gridDim.x; const int bx = blockIdx.x; const int vcu = (G % 8 == 0) ? (bx % 8) * (G / 8) + bx / 8 : bx;
    unsigned char* ws = P.ws;
    for (int u = tid; u < (LDS_BYTES - MISC_OFF) / 4; u += NTHREADS) MISC[u] = 0u;
    __syncthreads();
    const int lo = P.ph_lo, hi = P.ph_hi;
    XcdBarrier bar; bar.bar = (unsigned*)(ws + WS_CTL) + CW_BAR; bar.x = 0; bar.st = nullptr;
    if (hi - lo > 1) bar = xcd_barrier_post((unsigned*)(ws + WS_CTL) + CW_BAR, MISC + 8);
#define IN(k) (lo <= (k) && (k) < hi)
#define SEAM(k) do { if (IN(k) && IN((k) + 1)) { xcd_barrier(bar); if (PROBE_DUP == 99) xcd_barrier(bar); } } while (0)

    float* mod = (float*)(ws + WS_MOD);
    bf16_t* H = (bf16_t*)(ws + WS_H); bf16_t* U = (bf16_t*)(ws + WS_U); bf16_t* VG = (bf16_t*)(ws + WS_VG); bf16_t* Q = (bf16_t*)(ws + WS_Q); bf16_t* Kb = (bf16_t*)(ws + WS_K); bf16_t* Vb = (bf16_t*)(ws + WS_V);
    bf16_t* SA = (bf16_t*)(ws + WS_SA); bf16_t* SB = (bf16_t*)(ws + WS_SB); bf16_t* YAB = (bf16_t*)(ws + WS_YAB); bf16_t* MG = (bf16_t*)(ws + WS_MG);
    bf16_t* O = (bf16_t*)(ws + WS_O); bf16_t* F1 = (bf16_t*)(ws + WS_F1);

    if ((PH_MASK & 1) && IN(0)) { prologue_phase(P, lds, vcu, G, tid, wave, lane); if (PROBE_DUP == 0) { __syncthreads(); prologue_phase(P, lds, vcu, G, tid, wave, lane); } } SEAM(0);
    if ((PH_MASK & 2) && IN(1)) { norm_phase(P, lds, true, false, nullptr, 0, false, mod, 0, nullptr, mod, 0, P.g_pre_mix, H, vcu, G, wave, lane); } SEAM(1);

    for (int l = 0; l < NL; ++l) {
        const int pb = 2 + 8 * l;
        const float* modl = mod + (size_t)l * 3 * 6 * D;
        if ((PH_MASK & 4) && IN(pb + 0)) {
            pg8::Gemm g{H, (const bf16_t*)(ws + WS_WIN) + (size_t)l * NIN * D, D, D, D, M, NIN, 0};
            const bool spec = (G == 256);
            if (!spec || bx < 240) {
            pg8::StaticOrder S; S.init(M, NIN, D, spec ? 240 : G, bx);
            pg8::EpiIn E{U, Q, SA, P.out, (float2*)(ws + WS_STATS), (const float2*)(ws + WS_ROPE), l, 0};
            pg8::gemm_phase<pg8::EpiIn, pg8::StaticOrder, true>(lds, g, S, E);
            } else {
                {
                    int tl = tid; asm volatile("" : "+v"(tl));
                    const size_t n1 = (size_t)NH * PAST * HD, gtid = (size_t)(bx - 240) * NTHREADS + tl, gth = (size_t)16 * NTHREADS;
                    for (int b = 0; b < SBT; ++b) { const size_t off = ((size_t)b * NL + l) * n1;
                        cvt_flat(P.cache_k + off, (bf16_t*)(ws + WS_CK) + off, n1, gtid, gth); cvt_flat(P.cache_v + off, (bf16_t*)(ws + WS_CV) + off, n1, gtid, gth); } }
                conv_stream(P, l, I_IN + (bx - 240) * NWAVES + wave, I_IN + I_SPLITA, 16 * NWAVES, (LAS float*)(lds + wave * WLDS), lane); }
        }
        SEAM(pb + 0);
        if ((PH_MASK & 8) && IN(pb + 1)) {
            mix::MixArgs A{Q, Kb, Vb, (const bf16_t*)(ws + WS_CK), (const bf16_t*)(ws + WS_CV), U, VG, (const bf16_t*)(ws + WS_WS), (const float2*)(ws + WS_STATS),
                           P.na_rpb, P.sgu_ln_g, P.sgu_ln_b, P.sgu_b, YAB, P.out, l};
            mix::mix_phase(A, lds, (LAS unsigned*)(lds + MISC_OFF) + 16 + 8 * l, vcu, G, tid, wave, lane);
            if (PROBE_DUP == 3) mix::mix_phase(A, lds, (LAS unsigned*)(lds + MISC_OFF) + 64 + 8 * l, vcu, G, tid, wave, lane);
            if (PROBE_DUP >= 31 && PROBE_DUP <= 34) mix::mix_phase(A, lds, (LAS unsigned*)(lds + MISC_OFF) + 64 + 8 * l, vcu, G, tid, wave, lane, PROBE_DUP == 31 ? 1 : (PROBE_DUP == 32 ? 2 : (PROBE_DUP == 33 ? 4 : 0)));
        }
        SEAM(pb + 1);
        if ((PH_MASK & 16) && IN(pb + 2)) {
            pg8::Gemm g{YAB, (const bf16_t*)(ws + WS_WPAB) + (size_t)l * D * 2048, 2048, 2048, 2048, M, D, 0};
            const bool spec = (G == 256);
            if (!spec || bx < 160) {
            pg8::StaticOrder S; S.init(M, D, 2048, spec ? 160 : G, bx);
            pg8::EpiMerge E{SA, SB, MG};
            pg8::gemm_phase<pg8::EpiMerge, pg8::StaticOrder, true>(lds, g, S, E);
            } else { conv_stream2(P, l, I_IN + I_SPLITA + (bx - 160) * NWAVES + wave, I_LAYER, 96 * NWAVES, (LAS float*)(lds + wave * WLDS), lane);
                if (l + 1 < NL) conv_stream2(P, l + 1, (bx - 160) * NWAVES + wave, I_IN, 96 * NWAVES, (LAS float*)(lds + wave * WLDS), lane);
                state_stream(P, l, (bx - 160) * NWAVES + wave, 96 * NWAVES, lane); }
        }
        SEAM(pb + 2);
        if ((PH_MASK & 32) && IN(pb + 3)) {
            pg8::Gemm g{MG, (const bf16_t*)(ws + WS_WOUT) + (size_t)l * D * D, D, D, D, M, D, 0};
            pg8::TailSplit S; S.init(D, G, vcu, bx);
            pg8::EpiPart E{O, (size_t)(WS_O1 - WS_O) / 2, D, 0};
            pg8::gemm_phase<pg8::EpiPart, pg8::TailSplit, true>(lds, g, S, E);
            if (PROBE_DUP == 5) pg8::gemm_phase<pg8::EpiPart, pg8::TailSplit, true>(lds, g, S, E);
        }
        SEAM(pb + 3);
        if ((PH_MASK & 64) && IN(pb + 4)) { norm_phase(P, lds, false, false, O, (size_t)(WS_O1 - WS_O) / 2, G == 256, modl, 2, P.g_post_mix + (size_t)l * D, modl, 3, P.g_pre_ffn + (size_t)l * D, H, vcu, G, wave, lane); }
        SEAM(pb + 4);
        if ((PH_MASK & 128) && IN(pb + 5)) {
            pg8::Gemm g{H, (const bf16_t*)(ws + WS_WFF1) + (size_t)l * DFF * D, D, D, D, M, DFF, 0};
            pg8::StaticOrder S; S.init(M, DFF, D, G, bx);
            pg8::EpiBf16<2> E{F1, DFF, 0};
            pg8::gemm_phase<pg8::EpiBf16<2>, pg8::StaticOrder, true>(lds, g, S, E);
            if (PROBE_DUP == 7) pg8::gemm_phase<pg8::EpiBf16<2>, pg8::StaticOrder, true>(lds, g, S, E);
            if (PROBE_DUP == 40) { pg8::ProbeOrder PS; PS.S = S; PS.mask = -1; pg8::EpiBf16<2> E2{(bf16_t*)(ws + WS_END), DFF, 0}; pg8::gemm_phase<pg8::EpiBf16<2>, pg8::ProbeOrder, true>(lds, g, PS, E2); }
            if (PROBE_DUP == 43) { pg8::ProbeOrder PS; PS.S = S; PS.mask = -1; pg8::EpiFixed E4{(bf16_t*)(ws + WS_END), 0, 0}; pg8::gemm_phase<pg8::EpiFixed, pg8::ProbeOrder, true>(lds, g, PS, E4); }
            if (PROBE_DUP == 42) { pg8::ProbeOrder PS; PS.S = S; PS.mask = -1; pg8::EpiNone E3{0, 0}; pg8::gemm_phase<pg8::EpiNone, pg8::ProbeOrder, true>(lds, g, PS, E3); }
        }
        SEAM(pb + 5);
        if ((PH_MASK & 256) && IN(pb + 6)) {
            pg8::Gemm g{F1, (const bf16_t*)(ws + WS_WFF2) + (size_t)l * D * DFF, DFF, DFF, DFF, M, D, 0};
            pg8::TailSplit S; S.init(DFF, G, vcu, bx);
            pg8::EpiPart E{O, (size_t)(WS_O1 - WS_O) / 2, D, 0};
            pg8::gemm_phase<pg8::EpiPart, pg8::TailSplit, true>(lds, g, S, E);
            if (PROBE_DUP == 8) pg8::gemm_phase<pg8::EpiPart, pg8::TailSplit, true>(lds, g, S, E);
        }
        SEAM(pb + 6);
        if ((PH_MASK & 512) && IN(pb + 7)) {
            const bool lastl = (l == NL - 1);
            norm_phase(P, lds, false, lastl, O, (size_t)(WS_O1 - WS_O) / 2, G == 256, modl, 5, P.g_post_ffn + (size_t)l * D, lastl ? modl : modl + 3 * 6 * D, 0, lastl ? P.g_pre_mix : P.g_pre_mix + (size_t)(l + 1) * D, lastl ? (bf16_t*)nullptr : H, vcu, G, wave, lane);
        }
        SEAM(pb + 7);
    }
#undef IN
#undef SEAM
}
constexpr int N_PHASES = 2 + 8 * NL;

extern "C" void kernel_launch(void* const* d_in, const int* in_sizes, int n_in, void* d_out, int out_size, void* d_ws, size_t ws_size, hipStream_t stream) {
    static int grid = 0;
    if (grid == 0) {
        if (n_in != 23 || ws_size < WS_END + ((PROBE_DUP == 40 || PROBE_DUP == 43) ? 160 * MiB : 0) || (size_t)out_size != OUT_END) { fprintf(stderr, "kernel_launch: unexpected shapes n_in %d ws %zu (need %zu) out %d\n", n_in, ws_size, (size_t)WS_END, out_size); grid = -1; return; }
        int dev = 0, cus = 0, per_cu = 0;
        if (hipGetDevice(&dev) != hipSuccess || hipDeviceGetAttribute(&cus, hipDeviceAttributeMultiprocessorCount, dev) != hipSuccess) { grid = -1; return; }
        if (hipFuncSetAttribute((const void*)mk_fwd, hipFuncAttributeMaxDynamicSharedMemorySize, LDS_BYTES) != hipSuccess) { fprintf(stderr, "kernel_launch: hipFuncSetAttribute failed\n"); grid = -1; return; }
        if (hipOccupancyMaxActiveBlocksPerMultiprocessor(&per_cu, (const void*)mk_fwd, NTHREADS, LDS_BYTES) != hipSuccess || per_cu < 1) { fprintf(stderr, "kernel_launch: occupancy query says %d\n", per_cu); }
        (void)hipGetLastError();
        grid = cus < 256 ? cus : 256;
        while (256 % grid) --grid;
#ifdef FORCE_GRID
        grid = FORCE_GRID;
#endif
    }
    if (grid < 0) return;
    if (hipMemsetAsync((char*)d_ws + WS_CTL, 0, CTL_ZERO_BYTES, stream) != hipSuccess) return;
    Params p{};
    const float** pp = (const float**)&p;
    for (int i = 0; i < 23; ++i) pp[i] = (const float*)d_in[i];
    p.out = (float*)d_out; p.ws = (unsigned char*)d_ws;
#if MK_PER_PHASE
    for (int ph = 0; ph < N_PHASES; ++ph) { p.ph_lo = ph; p.ph_hi = ph + 1; hipLaunchKernelGGL(mk_fwd, dim3(grid), dim3(NTHREADS), LDS_BYTES, stream, p); }
#else
    p.ph_lo = 0; p.ph_hi = N_PHASES;
    hipLaunchKernelGGL(mk_fwd, dim3(grid), dim3(NTHREADS), LDS_BYTES, stream, p);
#endif
}
```
